# Optimizing an MI355X kernel written in HIP

```python
import math
import jax, jax.numpy as jnp
from jax import lax
import numpy as np

D_MODEL = 1024
BATCH = 1
SEQ = 16384
DEPTH = 4

CHUNK = 64
N_META = 16
SB_HEADS = 4
SB_HEAD_DIM = 64
SB_WIDTH = SB_HEADS * SB_HEAD_DIM
SSM_WIDTH = D_MODEL // 2
SSM_GROUP = 16
SSM_GROUPS = SSM_WIDTH // SSM_GROUP
SSM_STATE = 64
FFN_DIM = ((8 * D_MODEL // 3 + 127) // 128) * 128
CONV_WIDTH = 3
Q_BLOCK = 128
N_BRANCH = 2
IN_WIDTH = 3 * SB_WIDTH + SSM_WIDTH + N_BRANCH * D_MODEL
RMS_EPS = 1e-6
DT_MIN = 1e-3
DT_MAX = 1e-1
A_RE_MAX = -1e-4

kernel_name = "hybrid_stickbreak_s5_convffn"


def rmsnorm(x, g):
    xf = x.astype(jnp.float32)
    y = xf * lax.rsqrt(jnp.mean(xf * xf, axis=-1, keepdims=True) + RMS_EPS)
    return (y * g.astype(jnp.float32)).astype(x.dtype)


def stick_breaking_attention(q, k, v):
    b, l, h, dh = q.shape
    nb = l // Q_BLOCK
    q = q.transpose(0, 2, 1, 3)
    k = k.transpose(0, 2, 1, 3)
    v = v.transpose(0, 2, 1, 3)
    scale = dh ** -0.5
    ar = jnp.arange(Q_BLOCK)
    tri = (ar[:, None] >= ar[None, :]).astype(jnp.float32)

    def pair(p):
        def step(carry, s):
            acc, out, out_lo = carry
            second = s > p
            i = jnp.where(second, nb - 1 - p, p)
            j = jnp.where(second, nb - 1 - p - (s - p - 1), p - s)
            fresh = (s == 0) | (s == p + 1)
            acc = jnp.where(fresh, 0.0, acc)
            out = jnp.where(fresh, 0.0, out)
            qb = lax.dynamic_slice_in_dim(q, i * Q_BLOCK, Q_BLOCK, axis=2)
            kb = lax.dynamic_slice_in_dim(k, j * Q_BLOCK, Q_BLOCK, axis=2)
            vb = lax.dynamic_slice_in_dim(v, j * Q_BLOCK, Q_BLOCK, axis=2)
            z = jnp.einsum('bhqd,bhkd->bhqk', qb, kb) * scale
            mask = (j * Q_BLOCK + ar)[None, :] < (i * Q_BLOCK + ar)[:, None]
            log_keep = jnp.where(mask, jax.nn.log_sigmoid(-z), 0.0)
            rev = jnp.einsum('bhqk,kj->bhqj', log_keep, tri)
            attn = jnp.exp(jnp.where(mask, z + rev + acc[..., None], -jnp.inf))
            out = out + jnp.einsum('bhqk,bhkd->bhqd', attn, vb)
            acc = acc + jnp.sum(log_keep, axis=-1)
            out_lo = jnp.where(s == p, out, out_lo)
            return (acc, out, out_lo), None

        init = (jnp.zeros((b, h, Q_BLOCK), jnp.float32),
                jnp.zeros((b, h, Q_BLOCK, dh), jnp.float32),
                jnp.zeros((b, h, Q_BLOCK, dh), jnp.float32))
        (_, out_hi, out_lo), _ = lax.scan(step, init, jnp.arange(nb + 1))
        return out_lo, out_hi

    lo, hi = lax.map(pair, jnp.arange(nb // 2))
    blocks = jnp.concatenate([lo, hi[::-1]], axis=0)
    return blocks.transpose(1, 0, 3, 2, 4).reshape(b, l, h * dh)


def s5_ssm(u, a_re, a_im, log_step, b_re, b_im, c_re, c_im, d_skip):
    lam_re = jnp.minimum(a_re, A_RE_MAX)
    lam_im = a_im
    step = jnp.exp(log_step)[:, None]
    mag = jnp.exp(lam_re * step)
    abar_re = mag * jnp.cos(lam_im * step)
    abar_im = mag * jnp.sin(lam_im * step)
    den = lam_re * lam_re + lam_im * lam_im
    nr = abar_re - 1.0
    f_re = (nr * lam_re + abar_im * lam_im) / den
    f_im = (abar_im * lam_re - nr * lam_im) / den
    bbar_re = f_re[:, :, None] * b_re - f_im[:, :, None] * b_im
    bbar_im = f_re[:, :, None] * b_im + f_im[:, :, None] * b_re
    bu_re = jnp.einsum('blgh,gph->blgp', u, bbar_re)
    bu_im = jnp.einsum('blgh,gph->blgp', u, bbar_im)

    def combine(e1, e2):
        a1r, a1i, x1r, x1i = e1
        a2r, a2i, x2r, x2i = e2
        return (a2r * a1r - a2i * a1i,
                a2r * a1i + a2i * a1r,
                a2r * x1r - a2i * x1i + x2r,
                a2r * x1i + a2i * x1r + x2i)

    ar = jnp.broadcast_to(abar_re, bu_re.shape)
    ai = jnp.broadcast_to(abar_im, bu_re.shape)
    _, _, xr, xi = lax.associative_scan(combine, (ar, ai, bu_re, bu_im), axis=1)
    y = (jnp.einsum('blgp,ghp->blgh', xr, c_re)
         - jnp.einsum('blgp,ghp->blgh', xi, c_im)
         + d_skip * u)
    return y


def causal_dwconv(x, w, bias):
    l = x.shape[1]
    xp = jnp.pad(x, ((0, 0), (CONV_WIDTH - 1, 0), (0, 0)))
    return sum(xp[:, j:j + l] * w[j] for j in range(CONV_WIDTH)) + bias


def hybrid_layer(h, norm1_g, w_in, q_norm_g, k_norm_g, ssm_a_re, ssm_a_im, ssm_log_step,
                 ssm_b_re, ssm_b_im, ssm_c_re, ssm_c_im, ssm_d, w_glu, b_glu,
                 w_attn_proj, w_ssm_proj, w_o, norm2_g, w_up, conv_w, conv_b, w_down):
    b, l, _ = h.shape
    f32 = jnp.float32
    xn = rmsnorm(h, norm1_g)
    proj = xn @ w_in
    q, k, v, u, gates = jnp.split(
        proj, [SB_WIDTH, 2 * SB_WIDTH, 3 * SB_WIDTH, 3 * SB_WIDTH + SSM_WIDTH], axis=-1)
    q = rmsnorm(q.reshape(b, l, SB_HEADS, SB_HEAD_DIM), q_norm_g).astype(f32)
    k = rmsnorm(k.reshape(b, l, SB_HEADS, SB_HEAD_DIM), k_norm_g).astype(f32)
    v = v.reshape(b, l, SB_HEADS, SB_HEAD_DIM).astype(f32)
    attn = stick_breaking_attention(q, k, v).astype(h.dtype)

    uf = u.astype(f32).reshape(b, l, SSM_GROUPS, SSM_GROUP)
    y = s5_ssm(uf, ssm_a_re.astype(f32), ssm_a_im.astype(f32), ssm_log_step.astype(f32),
               ssm_b_re.astype(f32), ssm_b_im.astype(f32), ssm_c_re.astype(f32),
               ssm_c_im.astype(f32), ssm_d.astype(f32)).reshape(b, l, SSM_WIDTH)
    g = jax.nn.gelu(y)
    ssm = (g * jax.nn.sigmoid(g @ w_glu.astype(f32) + b_glu.astype(f32))).astype(h.dtype)

    gate_a, gate_s = jnp.split(gates, N_BRANCH, axis=-1)
    mixed = (jax.nn.sigmoid(gate_a) * (attn @ w_attn_proj)
             + jax.nn.sigmoid(gate_s) * (ssm @ w_ssm_proj))
    h = h + mixed @ w_o
    xn = rmsnorm(h, norm2_g)
    up = causal_dwconv(xn @ w_up, conv_w, conv_b)
    gate_f, val_f = jnp.split(up, 2, axis=-1)
    h = h + (jax.nn.silu(gate_f) * val_f) @ w_down
    return h


def setup_inputs(seed: int = 0) -> dict:
    key = jax.random.key(seed)
    ks = jax.random.split(key, 24)
    f32 = jnp.float32
    nrm = lambda k, shape, s: (jax.random.normal(k, shape, f32) * s).astype(f32)
    n_idx = jnp.arange(SSM_STATE, dtype=f32)
    log_step = jax.random.uniform(ks[8], (DEPTH, SSM_GROUPS), f32,
                                  math.log(DT_MIN), math.log(DT_MAX))
    return {
        "x": nrm(ks[0], (BATCH, SEQ, D_MODEL), 1.0),
        "meta_tokens": nrm(ks[1], (N_META, D_MODEL), 1.0),
        "norm1_g": 1.0 + nrm(ks[2], (DEPTH, D_MODEL), 0.01),
        "w_in": nrm(ks[3], (DEPTH, D_MODEL, IN_WIDTH), D_MODEL ** -0.5),
        "q_norm_g": 1.0 + nrm(ks[4], (DEPTH, SB_HEAD_DIM), 0.01),
        "k_norm_g": 1.0 + nrm(ks[5], (DEPTH, SB_HEAD_DIM), 0.01),
        "ssm_a_re": -0.5 * (1.0 + nrm(ks[6], (DEPTH, SSM_GROUPS, SSM_STATE), 0.01)),
        "ssm_a_im": math.pi * n_idx + nrm(ks[7], (DEPTH, SSM_GROUPS, SSM_STATE), 0.01),
        "ssm_log_step": log_step,
        "ssm_b_re": nrm(ks[9], (DEPTH, SSM_GROUPS, SSM_STATE, SSM_GROUP), (2 * SSM_GROUP) ** -0.5),
        "ssm_b_im": nrm(ks[10], (DEPTH, SSM_GROUPS, SSM_STATE, SSM_GROUP), (2 * SSM_GROUP) ** -0.5),
        "ssm_c_re": nrm(ks[11], (DEPTH, SSM_GROUPS, SSM_GROUP, SSM_STATE), (2 * SSM_STATE) ** -0.5),
        "ssm_c_im": nrm(ks[12], (DEPTH, SSM_GROUPS, SSM_GROUP, SSM_STATE), (2 * SSM_STATE) ** -0.5),
        "ssm_d": nrm(ks[13], (DEPTH, SSM_GROUPS, SSM_GROUP), 1.0),
        "w_glu": nrm(ks[14], (DEPTH, SSM_WIDTH, SSM_WIDTH), SSM_WIDTH ** -0.5),
        "b_glu": nrm(ks[15], (DEPTH, SSM_WIDTH), 0.01),
        "w_attn_proj": nrm(ks[16], (DEPTH, SB_WIDTH, D_MODEL), SB_WIDTH ** -0.5),
        "w_ssm_proj": nrm(ks[17], (DEPTH, SSM_WIDTH, D_MODEL), SSM_WIDTH ** -0.5),
        "w_o": nrm(ks[18], (DEPTH, D_MODEL, D_MODEL), D_MODEL ** -0.5),
        "norm2_g": 1.0 + nrm(ks[19], (DEPTH, D_MODEL), 0.01),
        "w_up": nrm(ks[20], (DEPTH, D_MODEL, 2 * FFN_DIM), D_MODEL ** -0.5),
        "conv_w": nrm(ks[21], (DEPTH, CONV_WIDTH, 2 * FFN_DIM), CONV_WIDTH ** -0.5),
        "conv_b": nrm(ks[22], (DEPTH, 2 * FFN_DIM), 0.01),
        "w_down": nrm(ks[23], (DEPTH, FFN_DIM, D_MODEL), FFN_DIM ** -0.5),
    }


def reference(x, meta_tokens, norm1_g, w_in, q_norm_g, k_norm_g, ssm_a_re, ssm_a_im, ssm_log_step,
              ssm_b_re, ssm_b_im, ssm_c_re, ssm_c_im, ssm_d, w_glu, b_glu,
              w_attn_proj, w_ssm_proj, w_o, norm2_g, w_up, conv_w, conv_b, w_down):
    b = x.shape[0]
    l_real = N_META + x.shape[1]
    l_pad = -(-l_real // (2 * Q_BLOCK)) * (2 * Q_BLOCK)
    meta = jnp.broadcast_to(meta_tokens[None].astype(x.dtype), (b, N_META, D_MODEL))
    h = jnp.concatenate([meta, x], axis=1)
    h = jnp.pad(h, ((0, 0), (0, l_pad - l_real), (0, 0)))
    for i in range(DEPTH):
        h = hybrid_layer(h, norm1_g[i], w_in[i], q_norm_g[i], k_norm_g[i],
                         ssm_a_re[i], ssm_a_im[i], ssm_log_step[i],
                         ssm_b_re[i], ssm_b_im[i], ssm_c_re[i], ssm_c_im[i], ssm_d[i],
                         w_glu[i], b_glu[i], w_attn_proj[i], w_ssm_proj[i], w_o[i],
                         norm2_g[i], w_up[i], conv_w[i], conv_b[i], w_down[i])
    return h[:, N_META:l_real]
```

```cpp
#include <hip/hip_runtime.h>
#include <hip/hip_cooperative_groups.h>
#include <cstdio>
namespace cg = cooperative_groups;

#define LAS __attribute__((address_space(3)))
typedef unsigned short bf16_t;
typedef short bf16x8 __attribute__((ext_vector_type(8)));
typedef float f32x4 __attribute__((ext_vector_type(4)));
typedef unsigned u32x4 __attribute__((ext_vector_type(4)));
typedef unsigned u32x2 __attribute__((ext_vector_type(2)));

constexpr int L = 16640, LREAL = 16400, NMETA = 16, DM = 1024, INW = 3328, FFN = 2816, FF2 = 5632, NLAYER = 4;
constexpr int NCHUNK = 129;
constexpr float ATT_EXIT = 1.9287498e-22f;

constexpr size_t WT_WIN = 0, WT_WGLU = WT_WIN + (size_t)INW * DM * 2, WT_WCAT = WT_WGLU + 512 * 512 * 2, WT_WO = WT_WCAT + 1024 * 768 * 2,
                 WT_WUP = WT_WO + 1024 * 1024 * 2, WT_WDN = WT_WUP + (size_t)FF2 * DM * 2, WT_LAYER = WT_WDN + (size_t)DM * FFN * 2;
constexpr size_t WS_WT = 0;
constexpr size_t WS_H = WS_WT + WT_LAYER * NLAYER;
constexpr size_t WS_HB = WS_H + (size_t)L * DM * 4;
constexpr size_t WS_SSQ = WS_HB + (size_t)(L + 2) * DM * 2;
constexpr size_t WS_TAB = WS_SSQ + (size_t)8 * 16 * L * 4;
constexpr size_t TAB_G = 9216;
constexpr size_t WS_SST = WS_TAB + TAB_G * 32 * NLAYER;
constexpr size_t WS_ACAT = WS_SST + (size_t)130 * 32 * 64 * 8;
constexpr size_t WS_PROJ = WS_ACAT + (size_t)L * 768 * 2;
constexpr size_t WS_BAR = WS_PROJ + (size_t)L * INW * 2;
constexpr size_t WS_END = WS_BAR + 16384;
constexpr size_t OUT_GB = 0, OUT_MIXED = (size_t)L * 512 * 2;

constexpr int LDS_STAGE = 131072, LDS_SS = LDS_STAGE + 12288, LDS_BYTES = LDS_SS + 16384;

struct Params { const float* in[24]; float* out; unsigned char* ws; };

typedef float f32x2_t __attribute__((ext_vector_type(2)));
typedef __bf16 bf16x2_t __attribute__((ext_vector_type(2)));
__device__ __forceinline__ unsigned cvt_pk_bf16(float lo, float hi) { const f32x2_t v = {lo, hi}; return __builtin_bit_cast(unsigned, __builtin_convertvector(v, bf16x2_t)); }
__device__ __forceinline__ float bf_lo(unsigned u) { return __uint_as_float(u << 16); }
__device__ __forceinline__ float bf_hi(unsigned u) { return __uint_as_float(u & 0xffff0000u); }
__device__ __forceinline__ float sigmoidf_(float x) { return __builtin_amdgcn_rcpf(1.f + __expf(-x)); }
__device__ __forceinline__ u32x4 pack8(f32x4 a, f32x4 b) { u32x4 r; r.x = cvt_pk_bf16(a[0], a[1]); r.y = cvt_pk_bf16(a[2], a[3]); r.z = cvt_pk_bf16(b[0], b[1]); r.w = cvt_pk_bf16(b[2], b[3]); return r; }
__device__ __forceinline__ void unpack8(u32x4 v, f32x4& a, f32x4& b) { a[0] = bf_lo(v.x); a[1] = bf_hi(v.x); a[2] = bf_lo(v.y); a[3] = bf_hi(v.y); b[0] = bf_lo(v.z); b[1] = bf_hi(v.z); b[2] = bf_lo(v.w); b[3] = bf_hi(v.w); }

__device__ __forceinline__ int lane_id_asm() { int ln; asm volatile("v_mbcnt_lo_u32_b32 %0, -1, 0\n\tv_mbcnt_hi_u32_b32 %0, -1, %0" : "=v"(ln)); return ln; }
__device__ __forceinline__ float lane_get(float v, int srclane) { return __builtin_bit_cast(float, __builtin_amdgcn_ds_bpermute(srclane << 2, __builtin_bit_cast(int, v))); }
template <int CTRL> __device__ __forceinline__ float dpp_ror(float x) { return __builtin_bit_cast(float, __builtin_amdgcn_mov_dpp(__builtin_bit_cast(int, x), CTRL, 0xf, 0xf, true)); }
template <int CTRL> __device__ __forceinline__ float dpp_shr_keep(float keep, float x) { return __builtin_bit_cast(float, __builtin_amdgcn_update_dpp(__builtin_bit_cast(int, keep), __builtin_bit_cast(int, x), CTRL, 0xf, 0xf, false)); }

namespace pg8 {
constexpr int BM = 256, BK = 64, HALF = 128, HTB = HALF * BK * 2, NXCD = 8, WGM = 8;
__device__ __forceinline__ int lds_byte(int r, int c) { const int st = (r >> 4) * 2 + (c >> 5), rr = r & 15, cc = c & 31, ob = rr * 64 + cc * 2; return st * 1024 + (ob ^ (((ob >> 9) & 1) << 5)); }
__device__ __forceinline__ void stage_rc(int b, int& R, int& C) { const int st = b / 1024, sb = b % 1024, swz = sb ^ (((sb >> 9) & 1) << 5); R = (st >> 1) * 16 + swz / 64; C = (st & 1) * 32 + (swz % 64) / 2; }
__device__ __forceinline__ int perm32(int rho) { const int n = rho >> 4, i = rho & 15; return 8 * (i >> 2) + 4 * n + (i & 3); }
struct Unit { int pm, pn; };
struct Gemm { const bf16_t* A; const bf16_t* Bt; int lda, ldb, K, nM, nN, rowstep; };
struct Order {
    int nM, nN, nwg, G, c, fixpn;
    __device__ void init(int nM_, int nN_, int G_, int c_) { nM = nM_; nN = nN_; nwg = nM * nN; G = G_; c = c_; fixpn = -1; }
    __device__ void init_column(int nM_, int pn_, int c_) { nM = nM_; nN = 1; nwg = nM_; G = 1 << 30; c = c_; fixpn = pn_; }
    __device__ bool next(int i, Unit& u) const {
        if (fixpn >= 0) { if (i > 0 || c < 0 || c >= nM) return false; u.pm = c; u.pn = fixpn; return true; }
        const long Lx = (long)i * G + c; if (Lx >= nwg) return false;
        int wgid = (int)Lx; { const int q = nwg / NXCD, r = nwg % NXCD, xcd = wgid % NXCD, off = wgid / NXCD; wgid = (xcd < r ? xcd * (q + 1) : r * (q + 1) + (xcd - r) * q) + off; }
        const int nig = WGM * nN, gid = wgid / nig, fm = gid * WGM, gsz = (nM - fm) < WGM ? (nM - fm) : WGM;
        u.pm = fm + ((wgid % nig) % gsz); u.pn = (wgid % nig) / gsz; return true;
    }
};
template <class Epi, int MID = -1>
__device__ __forceinline__ void gemm_phase(LAS unsigned char* lds, const Gemm g, const Order& S0, const Epi& E, const int wid) {
    Order S = S0; { int c_ = S.c; asm volatile("" : "+s"(c_)); S.c = c_; }
    const int lane = lane_id_asm(), tid = wid * 64 + lane,
              wr = wid >> 2, wc = wid & 3, fr = lane & 15, fq = lane >> 4;
    const int K = g.K, nt = K / BK;
    unsigned voffA[2], voffB[2];
#pragma unroll
    for (int i = 0; i < 2; ++i) { int R, C; stage_rc(tid * 16 + i * 8192, R, C); const int Rb = (R & ~31) + perm32(R & 31);
        voffA[i] = (unsigned)(R * g.lda + C) * 2u; voffB[i] = (unsigned)(Rb * g.ldb + C) * 2u; }
    const size_t kstep = (size_t)(BK * 2);
    const size_t hstepA = (size_t)HALF * g.lda * 2, hstepB = (size_t)HALF * g.ldb * 2;
    const size_t tstepA = (size_t)g.rowstep * g.lda * 2, tstepB = (size_t)BM * g.ldb * 2;
    const unsigned ldsw = (unsigned)wid * 1024u;
    const int aoff = lds_byte(wr * 64 + fr, fq * 8), boff = lds_byte(wc * 32 + fr, fq * 8);
#define PG8_SA(b, h) (((b) * 2 + (h)) * HTB)
#define PG8_SB(b, h) ((4 + (b) * 2 + (h)) * HTB)
#define PG8_STAGE(bufoff, gbase, voff) do { _Pragma("unroll") for (int _i = 0; _i < 2; ++_i) \
        __builtin_amdgcn_global_load_lds((const unsigned*)((const char*)(gbase) + (voff)[_i]), (LAS unsigned*)(lds + (bufoff) + ldsw + _i * 8192), 16, 0, 0); } while (0)
#define PG8_LDA(dst, b, h) do { _Pragma("unroll") for (int m = 0; m < 4; ++m) _Pragma("unroll") for (int k = 0; k < 2; ++k) dst[m][k] = *(const LAS bf16x8*)(lds + PG8_SA(b, h) + aoff + m * 2048 + k * 1024); } while (0)
#define PG8_LDB(dst, b, h) do { _Pragma("unroll") for (int n = 0; n < 2; ++n) _Pragma("unroll") for (int k = 0; k < 2; ++k) dst[n][k] = *(const LAS bf16x8*)(lds + PG8_SB(b, h) + boff + n * 2048 + k * 1024); } while (0)
#define PG8_MMA(ai, bj, At, Bt) do { __builtin_amdgcn_s_setprio(1); _Pragma("unroll") for (int m = 0; m < 4; ++m) _Pragma("unroll") for (int n = 0; n < 2; ++n) _Pragma("unroll") for (int k = 0; k < 2; ++k) \
        acc[ai][bj][m][n] = __builtin_amdgcn_mfma_f32_16x16x32_bf16(Bt[n][k], At[m][k], acc[ai][bj][m][n], 0, 0, 0); __builtin_amdgcn_s_setprio(0); } while (0)
#define PG8_WAIT_V(n) asm volatile("s_waitcnt vmcnt(" #n ")" ::: "memory")
#define PG8_WAIT_L(n) asm volatile("s_waitcnt lgkmcnt(" #n ")" ::: "memory")
#define PG8_BAR __builtin_amdgcn_s_barrier()
#define PG8_SCHED __builtin_amdgcn_sched_barrier(0)
    Unit cur, nxt; int ui = 0;
    if (!S.next(0, cur)) return;
    cur.pm = __builtin_amdgcn_readfirstlane(cur.pm); cur.pn = __builtin_amdgcn_readfirstlane(cur.pn);
    f32x4 acc[2][2][4][2];
#pragma unroll
    for (int a = 0; a < 2; ++a)
#pragma unroll
        for (int b = 0; b < 2; ++b)
#pragma unroll
            for (int m = 0; m < 4; ++m)
#pragma unroll
                for (int n = 0; n < 2; ++n) acc[a][b][m][n] = (f32x4){0.f, 0.f, 0.f, 0.f};
    bf16x8 At[4][2], B0[2][2], B1[2][2];
    const char* cA = (const char*)g.A + (size_t)cur.pm * tstepA; const char* cB = (const char*)g.Bt + (size_t)cur.pn * tstepB;
    if constexpr (Epi::PREFETCH) E.prefetch(cur, wid);
    PG8_STAGE(PG8_SB(0, 0), cB, voffB); PG8_STAGE(PG8_SA(0, 0), cA, voffA); PG8_STAGE(PG8_SB(0, 1), cB + hstepB, voffB); PG8_STAGE(PG8_SA(0, 1), cA + hstepA, voffA);
    if (wr == 1) PG8_BAR;
    PG8_WAIT_V(4); PG8_BAR;
    PG8_STAGE(PG8_SB(1, 0), cB + kstep, voffB); PG8_STAGE(PG8_SA(1, 0), cA + kstep, voffA); PG8_STAGE(PG8_SB(1, 1), cB + hstepB + kstep, voffB);
    PG8_WAIT_V(6); PG8_BAR;
    for (;;) {
        const bool has_next = __builtin_amdgcn_readfirstlane((int)S.next(ui + 1, nxt)) != 0; nxt.pm = __builtin_amdgcn_readfirstlane(nxt.pm); nxt.pn = __builtin_amdgcn_readfirstlane(nxt.pn);
        const char* nA = has_next ? (const char*)g.A + (size_t)nxt.pm * tstepA : cA; const char* nB = has_next ? (const char*)g.Bt + (size_t)nxt.pn * tstepB : cB;
        for (int t = 0; t < nt; t += 2) {
            if constexpr (MID >= 0) { if (t == MID) { const int ln = lane_id_asm(); E.mid(acc, cur, wr, wc, ln & 15, ln >> 4); } }
            const bool last = (t == nt - 2);
            const char* a1 = cA + (size_t)(t + 1) * kstep;
            const char* a2 = last ? nA : cA + (size_t)(t + 2) * kstep; const char* b2 = last ? nB : cB + (size_t)(t + 2) * kstep;
            const char* a3 = a2 + kstep; const char* b3 = b2 + kstep;
            PG8_LDB(B0, 0, 0); PG8_SCHED; PG8_LDA(At, 0, 0); PG8_STAGE(PG8_SA(1, 1), a1 + hstepA, voffA);
            PG8_WAIT_L(8); PG8_BAR; PG8_WAIT_L(0); PG8_MMA(0, 0, At, B0); PG8_BAR; PG8_SCHED;
            PG8_LDB(B1, 0, 1); PG8_STAGE(PG8_SB(0, 0), b2, voffB);
            PG8_BAR; PG8_WAIT_L(0); PG8_MMA(0, 1, At, B1); PG8_BAR;
            PG8_LDA(At, 0, 1); PG8_STAGE(PG8_SA(0, 0), a2, voffA);
            PG8_BAR; PG8_WAIT_L(0); PG8_MMA(1, 0, At, B0); PG8_BAR; PG8_SCHED;
            PG8_STAGE(PG8_SB(0, 1), b2 + hstepB, voffB);
            PG8_WAIT_V(6); PG8_BAR; PG8_MMA(1, 1, At, B1); PG8_BAR;
            PG8_LDB(B0, 1, 0); PG8_SCHED; PG8_LDA(At, 1, 0); PG8_STAGE(PG8_SA(0, 1), a2 + hstepA, voffA);
            PG8_WAIT_L(8); PG8_BAR; PG8_WAIT_L(0); PG8_MMA(0, 0, At, B0); PG8_BAR; PG8_SCHED;
            PG8_LDB(B1, 1, 1); PG8_STAGE(PG8_SB(1, 0), b3, voffB);
            PG8_BAR; PG8_WAIT_L(0); PG8_MMA(0, 1, At, B1); PG8_BAR;
            PG8_LDA(At, 1, 1); PG8_STAGE(PG8_SA(1, 0), a3, voffA);
            PG8_BAR; PG8_WAIT_L(0); PG8_MMA(1, 0, At, B0); PG8_BAR; PG8_SCHED;
            PG8_STAGE(PG8_SB(1, 1), b3 + hstepB, voffB);
            PG8_WAIT_V(6); PG8_BAR; PG8_MMA(1, 1, At, B1); PG8_BAR;
        }
        { const int ln = lane_id_asm(); E(acc, cur, wr, wc, ln & 15, ln >> 4); }
        if (!has_next) break;
        if constexpr (Epi::PREFETCH) E.prefetch(nxt, wid);
#pragma unroll
        for (int a = 0; a < 2; ++a)
#pragma unroll
            for (int b = 0; b < 2; ++b)
#pragma unroll
                for (int m = 0; m < 4; ++m)
#pragma unroll
                    for (int n = 0; n < 2; ++n) acc[a][b][m][n] = (f32x4){0.f, 0.f, 0.f, 0.f};
        cur = nxt; cA = nA; cB = nB; ++ui;
    }
    PG8_WAIT_V(0);
    if (wr == 0) PG8_BAR;
    PG8_BAR;
#undef PG8_SA
#undef PG8_SB
#undef PG8_STAGE
#undef PG8_LDA
#undef PG8_LDB
#undef PG8_MMA
#undef PG8_WAIT_V
#undef PG8_WAIT_L
#undef PG8_BAR
#undef PG8_SCHED
}
}
using pg8::Unit;
typedef f32x4 Acc[2][2][4][2];

struct EpiProj {
    static constexpr bool PREFETCH = true;
    bf16_t* proj; const float* ss; LAS float* RS; LAS float* SS;
    __device__ __forceinline__ void prefetch(const Unit& u, int wid) const {
        const int lane = lane_id_asm();
#pragma unroll
        for (int kk = 0; kk < 2; ++kk) { const int k = 2 * wid + kk;
#pragma unroll
            for (int q = 0; q < 4; ++q) __builtin_amdgcn_global_load_lds((const unsigned*)(ss + (size_t)k * L + u.pm * 256 + 64 * q + lane), (LAS unsigned*)(SS + k * 256 + 64 * q), 4, 0, 0); }
    }
    __device__ __forceinline__ void operator()(Acc& acc, const Unit& u, int wr, int wc, int fr, int fq) const {
        if (wr == 0) { const int lr = wc * 64 + fq * 16 + fr; float sum = 0.f;
#pragma unroll
            for (int k = 0; k < 16; ++k) sum += SS[k * 256 + lr];
            RS[lr] = rsqrtf(sum * (1.f / 1024.f) + 1e-6f); }
        asm volatile("s_waitcnt lgkmcnt(0)" ::: "memory"); __builtin_amdgcn_s_barrier(); asm volatile("" ::: "memory");
#pragma unroll
        for (int ai = 0; ai < 2; ++ai)
#pragma unroll
            for (int m = 0; m < 4; ++m) { const int lr = ai * 128 + wr * 64 + m * 16 + fr, row = u.pm * 256 + lr; const float rs = RS[lr];
#pragma unroll
                for (int bj = 0; bj < 2; ++bj) { const int col = u.pn * 256 + bj * 128 + wc * 32 + fq * 8;
                    *(u32x4*)(proj + (size_t)row * INW + col) = pack8(acc[ai][bj][m][0] * rs, acc[ai][bj][m][1] * rs); } asm volatile("" ::: "memory"); }
    }
};
struct EpiGlu {
    static constexpr bool PREFETCH = false;
    const bf16_t* gb; const float* bias; bf16_t* acat;
    __device__ __forceinline__ void operator()(Acc& acc, const Unit& u, int wr, int wc, int fr, int fq) const {
        const int col0 = u.pn * 256 + wc * 32 + fq * 8;
        f32x4 bv[2][2];
#pragma unroll
        for (int bj = 0; bj < 2; ++bj) { bv[bj][0] = *(const f32x4*)(bias + col0 + bj * 128); bv[bj][1] = *(const f32x4*)(bias + col0 + bj * 128 + 4); }
#pragma unroll
        for (int ai = 0; ai < 2; ++ai) {
            const int row0 = u.pm * 256 + ai * 128 + wr * 64 + fr;
            u32x4 gv[4][2];
#pragma unroll
            for (int m = 0; m < 4; ++m)
#pragma unroll
                for (int bj = 0; bj < 2; ++bj) gv[m][bj] = *(const u32x4*)(gb + (size_t)(row0 + m * 16) * 512 + col0 + bj * 128);
#pragma unroll
            for (int m = 0; m < 4; ++m)
#pragma unroll
                for (int bj = 0; bj < 2; ++bj) { f32x4 g0, g1; unpack8(gv[m][bj], g0, g1); f32x4 o0, o1;
#pragma unroll
                    for (int j = 0; j < 4; ++j) { o0[j] = g0[j] * sigmoidf_(acc[ai][bj][m][0][j] + bv[bj][0][j]); o1[j] = g1[j] * sigmoidf_(acc[ai][bj][m][1][j] + bv[bj][1][j]); }
                    *(u32x4*)(acat + (size_t)(row0 + m * 16) * 768 + 256 + col0 + bj * 128) = pack8(o0, o1); }
            asm volatile("" ::: "memory");
        }
    }
};
struct EpiMixF {
    static constexpr bool PREFETCH = false;
    const bf16_t* proj; bf16_t* mixed;
    static __device__ __forceinline__ float e_neg(float x) { return __expf(-fmaxf(x, -30.f)); }
    __device__ __forceinline__ void mid(Acc& acc, const Unit& u, int wr, int wc, int fr, int fq) const {
        const int col0 = u.pn * 256 + wc * 32 + fq * 8;
#pragma unroll
        for (int ai = 0; ai < 2; ++ai) { const int row0 = u.pm * 256 + ai * 128 + wr * 64 + fr;
            u32x4 av[4][2], sv[4][2];
#pragma unroll
            for (int m = 0; m < 4; ++m)
#pragma unroll
                for (int bj = 0; bj < 2; ++bj) { const bf16_t* gp = proj + (size_t)(row0 + m * 16) * INW + 1280 + col0 + bj * 128; av[m][bj] = *(const u32x4*)gp; sv[m][bj] = *(const u32x4*)(gp + 1024); }
#pragma unroll
            for (int m = 0; m < 4; ++m)
#pragma unroll
                for (int bj = 0; bj < 2; ++bj) { f32x4 a0, a1, s0, s1; unpack8(av[m][bj], a0, a1); unpack8(sv[m][bj], s0, s1);
#pragma unroll
                    for (int j = 0; j < 4; ++j) { acc[ai][bj][m][0][j] *= (1.f + e_neg(s0[j])) * __builtin_amdgcn_rcpf(1.f + __expf(-a0[j])); acc[ai][bj][m][1][j] *= (1.f + e_neg(s1[j])) * __builtin_amdgcn_rcpf(1.f + __expf(-a1[j])); } }
            asm volatile("" ::: "memory"); }
    }
    __device__ __forceinline__ void operator()(Acc& acc, const Unit& u, int wr, int wc, int fr, int fq) const {
        const int col0 = u.pn * 256 + wc * 32 + fq * 8;
#pragma unroll
        for (int ai = 0; ai < 2; ++ai) { const int row0 = u.pm * 256 + ai * 128 + wr * 64 + fr;
            u32x4 sv[4][2];
#pragma unroll
            for (int m = 0; m < 4; ++m)
#pragma unroll
                for (int bj = 0; bj < 2; ++bj) sv[m][bj] = *(const u32x4*)(proj + (size_t)(row0 + m * 16) * INW + 2304 + col0 + bj * 128);
#pragma unroll
            for (int m = 0; m < 4; ++m)
#pragma unroll
                for (int bj = 0; bj < 2; ++bj) { f32x4 s0, s1, o0, o1; unpack8(sv[m][bj], s0, s1);
#pragma unroll
                    for (int j = 0; j < 4; ++j) { o0[j] = acc[ai][bj][m][0][j] * __builtin_amdgcn_rcpf(1.f + e_neg(s0[j])); o1[j] = acc[ai][bj][m][1][j] * __builtin_amdgcn_rcpf(1.f + e_neg(s1[j])); }
                    *(u32x4*)(mixed + (size_t)(row0 + m * 16) * DM + col0 + bj * 128) = pack8(o0, o1); }
            asm volatile("" ::: "memory"); }
    }
};
struct EpiRes {
    static constexpr bool PREFETCH = false;
    float* h; bf16_t* hb; float* ss; float* out;
    __device__ __forceinline__ void operator()(Acc& acc, const Unit& u, int wr, int wc, int fr, int fq) const {
        const int col0 = u.pn * 256 + wc * 32 + fq * 8, ln4 = (fq * 16 + fr) * 4;
#pragma unroll
        for (int ai = 0; ai < 2; ++ai) {
            const int row0 = u.pm * 256 + ai * 128 + wr * 64 + fr;
            f32x4 hv[4][2][2];
#pragma unroll
            for (int m = 0; m < 4; ++m)
#pragma unroll
                for (int bj = 0; bj < 2; ++bj) { const float* hp = h + (size_t)(row0 + m * 16) * DM + col0 + bj * 128; hv[m][bj][0] = *(const f32x4*)hp; hv[m][bj][1] = *(const f32x4*)(hp + 4); }
#pragma unroll
            for (int m = 0; m < 4; ++m) { const int row = row0 + m * 16; float sq = 0.f;
#pragma unroll
                for (int bj = 0; bj < 2; ++bj) { float* hp = h + (size_t)row * DM + col0 + bj * 128;
                    const f32x4 a = hv[m][bj][0] + acc[ai][bj][m][0], b = hv[m][bj][1] + acc[ai][bj][m][1];
                    if (!out) { *(f32x4*)hp = a; *(f32x4*)(hp + 4) = b; }
                    if (ss) { *(u32x4*)(hb + (size_t)row * DM + col0 + bj * 128) = pack8(a, b);
                        sq += a[0] * a[0] + a[1] * a[1] + a[2] * a[2] + a[3] * a[3] + b[0] * b[0] + b[1] * b[1] + b[2] * b[2] + b[3] * b[3]; }
                    if (out && row >= NMETA && row < LREAL) { float* op = out + (size_t)(row - NMETA) * DM + col0 + bj * 128; *(f32x4*)op = a; *(f32x4*)(op + 4) = b; } }
                if (ss) { sq += __builtin_bit_cast(float, __builtin_amdgcn_ds_bpermute(ln4 ^ 64, __builtin_bit_cast(int, sq))); sq += __builtin_bit_cast(float, __builtin_amdgcn_ds_bpermute(ln4 ^ 128, __builtin_bit_cast(int, sq)));
                    if (fq == 0) ss[(size_t)(u.pn * 4 + wc) * L + row] = sq; } }
            asm volatile("" ::: "memory");
        }
    }
};
struct EpiUp {
    static constexpr bool PREFETCH = true;
    bf16_t* act; const float* ss; const float* cw; const float* cb; LAS float* X; LAS float* SS;
    __device__ __forceinline__ void prefetch(const Unit& u, int wid) const {
        const int lane = lane_id_asm();
#pragma unroll
        for (int kk = 0; kk < 2; ++kk) { const int k = 2 * wid + kk;
#pragma unroll
            for (int q = 0; q < 4; ++q) { int row = u.pm * 254 - 2 + 64 * q + lane; row = row < 0 ? 0 : row;
                __builtin_amdgcn_global_load_lds((const unsigned*)(ss + (size_t)k * L + row), (LAS unsigned*)(SS + k * 256 + 64 * q), 4, 0, 0); } }
        if (wid >= 4) { const int w4 = wid - 4, r8 = 2 * w4 + (lane >> 5), c4 = (lane & 31) * 4;     const float* src = ((r8 & 3) == 3 ? cb : cw + (r8 & 3) * FF2) + (r8 >> 2) * FFN + u.pn * 128 + c4;
            __builtin_amdgcn_global_load_lds((const unsigned*)src, (LAS unsigned*)(X + 1792 + 2 * w4 * 128), 16, 0, 0); }
    }
    __device__ __forceinline__ void operator()(Acc& acc, const Unit& u, int wr, int wc, int fr, int fq) const {
        LAS float* RS = X + 1536;
        LAS float* CW = X + 1792;
        if (wr == 0) { const int lr = wc * 64 + fq * 16 + fr; float sum = 0.f;
#pragma unroll
            for (int k = 0; k < 16; ++k) sum += SS[k * 256 + lr];
            RS[lr] = rsqrtf(sum * (1.f / 1024.f) + 1e-6f); }
        asm volatile("s_waitcnt lgkmcnt(0)" ::: "memory"); __builtin_amdgcn_s_barrier(); asm volatile("" ::: "memory");
#pragma unroll
        for (int ai = 0; ai < 2; ++ai)
#pragma unroll
            for (int m = 0; m < 4; ++m) { const float rs = RS[ai * 128 + wr * 64 + m * 16 + fr];
#pragma unroll
                for (int bj = 0; bj < 2; ++bj) { acc[ai][bj][m][0] *= rs; acc[ai][bj][m][1] *= rs; } }
        const int cl = wc * 32 + fq * 8;
        if (fr >= 14) {
#pragma unroll
            for (int ai = 0; ai < 2; ++ai) { const int s = 2 * ai + wr; if (s < 3) {
#pragma unroll
                for (int bj = 0; bj < 2; ++bj)
#pragma unroll
                    for (int n = 0; n < 2; ++n) *(LAS f32x4*)(X + ((s * 2 + (fr - 14)) * 2 + bj) * 128 + cl + 4 * n) = acc[ai][bj][3][n]; } }
        }
        asm volatile("s_waitcnt lgkmcnt(0)" ::: "memory"); __builtin_amdgcn_s_barrier(); asm volatile("" ::: "memory"); __builtin_amdgcn_s_barrier(); asm volatile("" ::: "memory");
#pragma unroll
        for (int n = 0; n < 2; ++n) {
            const int ch = u.pn * 128 + cl + 4 * n;
#pragma unroll
            for (int ai = 0; ai < 2; ++ai) {
                const int s = 2 * ai + wr;
                {
                    const LAS float* cwp = CW + cl + 4 * n; const f32x4 w0 = *(const LAS f32x4*)(cwp), w1 = *(const LAS f32x4*)(cwp + 128), w2 = *(const LAS f32x4*)(cwp + 256), bb = *(const LAS f32x4*)(cwp + 384);
                    f32x4 R1 = {0.f, 0.f, 0.f, 0.f}, R2 = R1;
                    if (s > 0) { const LAS float* xp = X + ((s - 1) * 2) * 2 * 128 + cl + 4 * n; const f32x4 e2 = *(const LAS f32x4*)(xp), e1 = *(const LAS f32x4*)(xp + 256); R1 = e1; R2 = fr == 0 ? e2 : e1; }
#pragma unroll
                    for (int m = 0; m < 4; ++m) { const f32x4 x = acc[ai][0][m][n]; f32x4 p1, p2;
#pragma unroll
                        for (int j = 0; j < 4; ++j) { p1[j] = dpp_shr_keep<0x111>(R1[j], x[j]); p2[j] = dpp_shr_keep<0x112>(R2[j], x[j]); R1[j] = dpp_ror<0x121>(x[j]); R2[j] = dpp_ror<0x122>(x[j]); }
                        acc[ai][0][m][n] = bb + w0 * p2 + w1 * p1 + w2 * x; __builtin_amdgcn_sched_barrier(0); }
                }
                asm volatile("" ::: "memory");
                {
                    const LAS float* cwp = CW + 512 + cl + 4 * n; const f32x4 w0 = *(const LAS f32x4*)(cwp), w1 = *(const LAS f32x4*)(cwp + 128), w2 = *(const LAS f32x4*)(cwp + 256), bb = *(const LAS f32x4*)(cwp + 384);
                    f32x4 R1 = {0.f, 0.f, 0.f, 0.f}, R2 = R1;
                    if (s > 0) { const LAS float* xp = X + ((s - 1) * 2) * 2 * 128 + 128 + cl + 4 * n; const f32x4 e2 = *(const LAS f32x4*)(xp), e1 = *(const LAS f32x4*)(xp + 256); R1 = e1; R2 = fr == 0 ? e2 : e1; }
#pragma unroll
                    for (int m = 0; m < 4; ++m) { const f32x4 x = acc[ai][1][m][n]; f32x4 p1, p2;
#pragma unroll
                        for (int j = 0; j < 4; ++j) { p1[j] = dpp_shr_keep<0x111>(R1[j], x[j]); p2[j] = dpp_shr_keep<0x112>(R2[j], x[j]); R1[j] = dpp_ror<0x121>(x[j]); R2[j] = dpp_ror<0x122>(x[j]); }
                        const f32x4 cvv = bb + w0 * p2 + w1 * p1 + w2 * x;
                        f32x4 o;
#pragma unroll
                        for (int j = 0; j < 4; ++j) { const float cgj = acc[ai][0][m][n][j]; o[j] = cgj * sigmoidf_(cgj) * cvv[j]; }
                        const int lr = ai * 128 + wr * 64 + m * 16 + fr, row = u.pm * 254 - 2 + lr;
                        if (lr >= 2 && row < L) { u32x2 w; w.x = cvt_pk_bf16(o[0], o[1]); w.y = cvt_pk_bf16(o[2], o[3]); *(u32x2*)(act + (size_t)row * FFN + ch) = w; } __builtin_amdgcn_sched_barrier(0); }
                }
                asm volatile("" ::: "memory");
            }
        }
    }
};

__device__ __forceinline__ void sincos_f64(double x, double& s, double& c) {
    const double kd = rint(x * 6.36619772367581382433e-01);
    double r = fma(-kd, 1.57079632673412561417e+00, x); r = fma(-kd, 6.07710050650619224932e-11, r);
    const double z = r * r;
    const double ps = -1.66666666666666324348e-01 + z * (8.33333333332248946124e-03 + z * (-1.98412698298579493134e-04 + z * (2.75573137070700676789e-06 + z * (-2.50507602534068634195e-08 + z * 1.58969099521155010221e-10))));
    const double pc = 4.16666666666666019037e-02 + z * (-1.38888888888741095749e-03 + z * (2.48015872894767294178e-05 + z * (-2.75573143513906633035e-07 + z * (2.08757232129817482790e-09 + z * -1.13596475577881948265e-11))));
    const double sr = r + r * z * ps, cr = 1.0 - 0.5 * z + z * z * pc;
    const int q = ((int)kd) & 3;
    s = (q == 0) ? sr : (q == 1) ? cr : (q == 2) ? -sr : -cr;
    c = (q == 0) ? cr : (q == 1) ? -sr : (q == 2) ? -cr : sr;
}
__device__ void transpose_tile(int tid, float* T, const float* W, int N, int k0, int n0, const float* gain, bf16_t* Wt, int ldb, int koff, int upperm) {
    { const int kk = tid >> 3, c8 = (tid & 7) * 8; const float* src = W + (size_t)(k0 + kk) * N + n0 + c8;
      const f32x4 a = *(const f32x4*)src, b = *(const f32x4*)(src + 4); const float gs = gain ? gain[k0 + kk] : 1.f;
#pragma unroll
      for (int i = 0; i < 4; ++i) { T[kk * 65 + c8 + i] = a[i] * gs; T[kk * 65 + c8 + 4 + i] = b[i] * gs; } }
    __syncthreads();
    { const int nn = tid >> 3, k8 = (tid & 7) * 8; f32x4 a, b;
#pragma unroll
      for (int i = 0; i < 4; ++i) { a[i] = T[(k8 + i) * 65 + nn]; b[i] = T[(k8 + 4 + i) * 65 + nn]; }
      int n = n0 + nn;
      if (upperm) { const int c = n < FFN ? n : n - FFN; n = 256 * (c >> 7) + (n < FFN ? 0 : 128) + (c & 127); }
      *(u32x4*)(Wt + (size_t)n * ldb + koff + k0 + k8) = pack8(a, b); }
    __syncthreads();
}

__device__ void prep_phase(const Params& p, unsigned char* shm, const int w) {
    const int G = gridDim.x, b = blockIdx.x, lane = lane_id_asm(), tid = w * 64 + lane;
    unsigned char* ws = p.ws;
    constexpr int T_WIN = 16 * 52, T_GLU = 64, T_AP = 64, T_SP = 128, T_WO = 256, T_UP = 16 * 88, T_DN = 44 * 16, T_LAYER = T_WIN + T_GLU + T_AP + T_SP + T_WO + T_UP + T_DN;
    for (int idx = b; idx < T_LAYER * NLAYER; idx += G) {
        const int l = idx / T_LAYER; int r = idx % T_LAYER;
        unsigned char* wt = ws + WS_WT + (size_t)l * WT_LAYER;
        float* T = (float*)shm;
        if (r < T_WIN) { transpose_tile(tid, T, p.in[3] + (size_t)l * DM * INW, INW, (r / 52) * 64, (r % 52) * 64, p.in[2] + l * DM, (bf16_t*)(wt + WT_WIN), DM, 0, 0); continue; } r -= T_WIN;
        if (r < T_GLU) { transpose_tile(tid, T, p.in[14] + (size_t)l * 512 * 512, 512, (r / 8) * 64, (r % 8) * 64, nullptr, (bf16_t*)(wt + WT_WGLU), 512, 0, 0); continue; } r -= T_GLU;
        if (r < T_AP) { transpose_tile(tid, T, p.in[16] + (size_t)l * 256 * DM, DM, (r / 16) * 64, (r % 16) * 64, nullptr, (bf16_t*)(wt + WT_WCAT), 768, 0, 0); continue; } r -= T_AP;
        if (r < T_SP) { transpose_tile(tid, T, p.in[17] + (size_t)l * 512 * DM, DM, (r / 16) * 64, (r % 16) * 64, nullptr, (bf16_t*)(wt + WT_WCAT), 768, 256, 0); continue; } r -= T_SP;
        if (r < T_WO) { transpose_tile(tid, T, p.in[18] + (size_t)l * DM * DM, DM, (r / 16) * 64, (r % 16) * 64, nullptr, (bf16_t*)(wt + WT_WO), DM, 0, 0); continue; } r -= T_WO;
        if (r < T_UP) { transpose_tile(tid, T, p.in[20] + (size_t)l * DM * FF2, FF2, (r / 88) * 64, (r % 88) * 64, p.in[19] + l * DM, (bf16_t*)(wt + WT_WUP), DM, 0, 1); continue; } r -= T_UP;
        transpose_tile(tid, T, p.in[23] + (size_t)l * FFN * DM, DM, (r / 16) * 64, (r % 16) * 64, nullptr, (bf16_t*)(wt + WT_WDN), FFN, 0, 0);
    }
    float* h = (float*)(ws + WS_H); bf16_t* hb = (bf16_t*)(ws + WS_HB) + 2 * DM; float* ssq = (float*)(ws + WS_SSQ);
    for (int row = b * 8 + w; row < L; row += G * 8) {
        float sq = 0.f;
#pragma unroll
        for (int i = 0; i < 4; ++i) { const int col = i * 256 + lane * 4; f32x4 v = {0.f, 0.f, 0.f, 0.f};
            if (row < NMETA) v = *(const f32x4*)(p.in[1] + (size_t)row * DM + col); else if (row < LREAL) v = *(const f32x4*)(p.in[0] + (size_t)(row - NMETA) * DM + col);
            *(f32x4*)(h + (size_t)row * DM + col) = v; u32x2 wv; wv.x = cvt_pk_bf16(v[0], v[1]); wv.y = cvt_pk_bf16(v[2], v[3]); *(u32x2*)(hb + (size_t)row * DM + col) = wv;
            sq += v[0] * v[0] + v[1] * v[1] + v[2] * v[2] + v[3] * v[3]; }
#pragma unroll
        for (int o = 32; o > 0; o >>= 1) sq += lane_get(sq, lane ^ o);
        if (lane < 16) ssq[(size_t)lane * L + row] = lane == 0 ? sq : 0.f;
    }
    for (int i = b * 512 + tid; i < 7 * 16 * L; i += G * 512) ssq[(size_t)16 * L + i] = 0.f;
    for (int i = b * 512 + tid; i < 2 * DM / 2; i += G * 512) ((unsigned*)(ws + WS_HB))[i] = 0u;
    for (int i = b * 512 + tid; i < (L - NCHUNK * 128) * 512 / 2; i += G * 512) ((unsigned*)((unsigned char*)p.out + OUT_GB) + (size_t)NCHUNK * 128 * 512 / 2)[i] = 0u;
    for (int i = b * 512 + tid; i < (L - LREAL) * INW / 2; i += G * 512) ((unsigned*)(ws + WS_PROJ) + (size_t)LREAL * INW / 2)[i] = 0u;
    for (int i = b * 512 + tid; i < NLAYER * 32 * 64; i += G * 512) {
        const int l = i >> 11, g = (i >> 6) & 31, pp = i & 63;
        const double a_re = (double)p.in[6][i], lam_im = (double)p.in[7][i]; const double lam_re = a_re < -1e-4 ? a_re : -1e-4;
        const double step = exp((double)p.in[8][l * 32 + g]);
        const double mag = exp(lam_re * step); double sn, cs; sincos_f64(lam_im * step, sn, cs);
        const double abr = mag * cs, abi = mag * sn, den = lam_re * lam_re + lam_im * lam_im, nr = abr - 1.0;
        const double f_re = (nr * lam_re + abi * lam_im) / den, f_im = (abi * lam_re - nr * lam_im) / den;
        double tr = abr, ti = abi;
#pragma unroll 1
        for (int k = 0; k < 7; ++k) { const double nr2 = tr * tr - ti * ti, ni2 = 2.0 * tr * ti; tr = nr2; ti = ni2; }
        unsigned char* tab = ws + WS_TAB + (size_t)(l * 32 + g) * TAB_G;
        ((float2*)tab)[pp] = make_float2((float)abr, (float)abi); ((float2*)(tab + 512))[pp] = make_float2((float)tr, (float)ti);
        bf16_t* Bm = (bf16_t*)(tab + 1024); bf16_t* Cm = (bf16_t*)(tab + 1024 + 4096);
        const float* bre = p.in[9] + (size_t)i * 16; const float* bim = p.in[10] + (size_t)i * 16;
#pragma unroll
        for (int hh = 0; hh < 16; hh += 2) {
            const double r0 = f_re * bre[hh] - f_im * bim[hh], i0 = f_re * bim[hh] + f_im * bre[hh], r1 = f_re * bre[hh + 1] - f_im * bim[hh + 1], i1 = f_re * bim[hh + 1] + f_im * bre[hh + 1];
            *(unsigned*)(Bm + pp * 16 + hh) = cvt_pk_bf16((float)r0, (float)r1); *(unsigned*)(Bm + (64 + pp) * 16 + hh) = cvt_pk_bf16((float)i0, (float)i1); }
        const float* cre = p.in[11] + (size_t)(l * 32 + g) * 16 * 64; const float* cim = p.in[12] + (size_t)(l * 32 + g) * 16 * 64;
        for (int hh = 0; hh < 16; ++hh) { Cm[hh * 128 + pp] = (bf16_t)(cvt_pk_bf16(cre[hh * 64 + pp], 0.f) & 0xffffu); Cm[hh * 128 + 64 + pp] = (bf16_t)(cvt_pk_bf16(-cim[hh * 64 + pp], 0.f) & 0xffffu); }
    }
}

__device__ void attn_item(const int w, unsigned char* shm, const bf16_t* proj, bf16_t* acat, const float* qg, const float* kg, int qb, int head) {
    bf16_t* Qs = (bf16_t*)shm; bf16_t* Ks = (bf16_t*)(shm + 18432); bf16_t* Vt = (bf16_t*)(shm + 36864); float* Sb = (float*)(shm + 54272); float* red = (float*)(shm + 121856);
    const int lane = lane_id_asm(), tid = w * 64 + lane, fr = lane & 15, fq = lane >> 4;
    { const int row = tid >> 2, seg = tid & 3; const bf16_t* src = proj + (size_t)(qb * 128 + row) * INW + head * 64 + seg * 16;
      f32x4 x0, x1, x2, x3; unpack8(*(const u32x4*)src, x0, x1); unpack8(*(const u32x4*)(src + 8), x2, x3);
      float ss = 0.f;
#pragma unroll
      for (int i = 0; i < 4; ++i) ss += x0[i] * x0[i] + x1[i] * x1[i] + x2[i] * x2[i] + x3[i] * x3[i];
      ss += lane_get(ss, lane ^ 1); ss += lane_get(ss, lane ^ 2);
      const float rs = rsqrtf(ss * (1.f / 64.f) + 1e-6f) * 0.125f;
      const f32x4 g0 = *(const f32x4*)(qg + seg * 16), g1 = *(const f32x4*)(qg + seg * 16 + 4), g2 = *(const f32x4*)(qg + seg * 16 + 8), g3 = *(const f32x4*)(qg + seg * 16 + 12);
      *(u32x4*)(Qs + row * 72 + seg * 16) = pack8(x0 * g0 * rs, x1 * g1 * rs); *(u32x4*)(Qs + row * 72 + seg * 16 + 8) = pack8(x2 * g2 * rs, x3 * g3 * rs); }
    f32x4 O[4];
#pragma unroll
    for (int i = 0; i < 4; ++i) O[i] = (f32x4){0.f, 0.f, 0.f, 0.f};
    float accr = 1.f;
    const bf16_t* ksrc = proj + (size_t)(qb * 128 + (tid >> 2)) * INW + 256 + head * 64 + (tid & 3) * 16;
    const bf16_t* vsrc = proj + (size_t)(qb * 128 + (tid & 127)) * INW + 512 + head * 64 + (tid >> 7) * 16;
    u32x4 kn0 = *(const u32x4*)ksrc, kn1 = *(const u32x4*)(ksrc + 8), vn0 = *(const u32x4*)vsrc, vn1 = *(const u32x4*)(vsrc + 8);
    for (int kb = qb; kb >= 0; --kb) {
        const u32x4 kc0 = kn0, kc1 = kn1, vc0 = vn0, vc1 = vn1;
        if (kb > 0) { ksrc -= (size_t)128 * INW; vsrc -= (size_t)128 * INW; kn0 = *(const u32x4*)ksrc; kn1 = *(const u32x4*)(ksrc + 8); vn0 = *(const u32x4*)vsrc; vn1 = *(const u32x4*)(vsrc + 8); }
        { const int row = tid >> 2, seg = tid & 3;
          f32x4 x0, x1, x2, x3; unpack8(kc0, x0, x1); unpack8(kc1, x2, x3);
          float ss = 0.f;
#pragma unroll
          for (int i = 0; i < 4; ++i) ss += x0[i] * x0[i] + x1[i] * x1[i] + x2[i] * x2[i] + x3[i] * x3[i];
          ss += lane_get(ss, lane ^ 1); ss += lane_get(ss, lane ^ 2);
          const float rs = rsqrtf(ss * (1.f / 64.f) + 1e-6f);
          const f32x4 g0 = *(const f32x4*)(kg + seg * 16), g1 = *(const f32x4*)(kg + seg * 16 + 4), g2 = *(const f32x4*)(kg + seg * 16 + 8), g3 = *(const f32x4*)(kg + seg * 16 + 12);
          *(u32x4*)(Ks + row * 72 + seg * 16) = pack8(x0 * g0 * rs, x1 * g1 * rs); *(u32x4*)(Ks + row * 72 + seg * 16 + 8) = pack8(x2 * g2 * rs, x3 * g3 * rs); }
        { const int row = tid & 127, seg = tid >> 7;
          const u32x4 a = vc0, b = vc1; bf16_t* vp = Vt + (seg * 16) * 136 + row;
          vp[0 * 136] = (bf16_t)(a.x & 0xffffu); vp[1 * 136] = (bf16_t)(a.x >> 16); vp[2 * 136] = (bf16_t)(a.y & 0xffffu); vp[3 * 136] = (bf16_t)(a.y >> 16);
          vp[4 * 136] = (bf16_t)(a.z & 0xffffu); vp[5 * 136] = (bf16_t)(a.z >> 16); vp[6 * 136] = (bf16_t)(a.w & 0xffffu); vp[7 * 136] = (bf16_t)(a.w >> 16);
          vp[8 * 136] = (bf16_t)(b.x & 0xffffu); vp[9 * 136] = (bf16_t)(b.x >> 16); vp[10 * 136] = (bf16_t)(b.y & 0xffffu); vp[11 * 136] = (bf16_t)(b.y >> 16);
          vp[12 * 136] = (bf16_t)(b.z & 0xffffu); vp[13 * 136] = (bf16_t)(b.z >> 16); vp[14 * 136] = (bf16_t)(b.w & 0xffffu); vp[15 * 136] = (bf16_t)(b.w >> 16); }
        __syncthreads();
        { const int qt0 = 2 * (w >> 1), kt0 = 4 * (w & 1);
          f32x4 s[2][4];
#pragma unroll
          for (int a = 0; a < 2; ++a)
#pragma unroll
              for (int c = 0; c < 4; ++c) s[a][c] = (f32x4){0.f, 0.f, 0.f, 0.f};
#pragma unroll
          for (int ks = 0; ks < 2; ++ks) { bf16x8 qf[2], kf[4];
#pragma unroll
              for (int a = 0; a < 2; ++a) qf[a] = *(const bf16x8*)(Qs + (16 * (qt0 + a) + fr) * 72 + 32 * ks + 8 * fq);
#pragma unroll
              for (int c = 0; c < 4; ++c) kf[c] = *(const bf16x8*)(Ks + (16 * (kt0 + c) + fr) * 72 + 32 * ks + 8 * fq);
#pragma unroll
              for (int a = 0; a < 2; ++a)
#pragma unroll
                  for (int c = 0; c < 4; ++c) s[a][c] = __builtin_amdgcn_mfma_f32_16x16x32_bf16(kf[c], qf[a], s[a][c], 0, 0, 0); }
#pragma unroll
          for (int a = 0; a < 2; ++a)
#pragma unroll
              for (int c = 0; c < 4; ++c) *(f32x4*)(Sb + (16 * (qt0 + a) + fr) * 132 + 16 * (kt0 + c) + 4 * fq) = s[a][c]; }
        __syncthreads();
        const int row = tid >> 2, qq = tid & 3;
        float z[32];
#pragma unroll
        for (int i = 0; i < 8; ++i) { const f32x4 v = *(const f32x4*)(Sb + row * 132 + 32 * qq + 4 * i); z[4 * i] = v[0]; z[4 * i + 1] = v[1]; z[4 * i + 2] = v[2]; z[4 * i + 3] = v[3]; }
        __syncthreads();
        { const int lim = (kb == qb) ? (row - 32 * qq) : 1000;
          float keep = 1.f;
#pragma unroll
          for (int k = 31; k >= 0; --k) { const float e = __expf(-fmaxf(z[k], -80.f)); const float sg = __builtin_amdgcn_rcpf(1.f + e), om = e * sg;
              const bool vis = k < lim; z[k] = vis ? sg * keep : 0.f; keep = vis ? keep * om : keep; }
          const int lb = lane & ~3; const float t0 = lane_get(keep, lb), t1 = lane_get(keep, lb + 1), t2 = lane_get(keep, lb + 2), t3 = lane_get(keep, lb + 3);
          const float off = (qq < 1 ? t1 : 1.f) * (qq < 2 ? t2 : 1.f) * (qq < 3 ? t3 : 1.f) * accr;
          bf16_t* pp = (bf16_t*)(Sb + row * 132) + 32 * qq;
#pragma unroll
          for (int i = 0; i < 4; ++i) { u32x4 o; o.x = cvt_pk_bf16(z[8 * i] * off, z[8 * i + 1] * off); o.y = cvt_pk_bf16(z[8 * i + 2] * off, z[8 * i + 3] * off);
              o.z = cvt_pk_bf16(z[8 * i + 4] * off, z[8 * i + 5] * off); o.w = cvt_pk_bf16(z[8 * i + 6] * off, z[8 * i + 7] * off); *(u32x4*)(pp + 8 * i) = o; }
          accr *= (t0 * t1) * (t2 * t3);
          float mx = accr;
#pragma unroll
          for (int o = 32; o > 0; o >>= 1) mx = fmaxf(mx, lane_get(mx, lane ^ o));
          if (lane == 0) red[w] = mx; }
        __syncthreads();
#pragma unroll
        for (int ks = 0; ks < 4; ++ks) { const bf16x8 pf = *(const bf16x8*)((const bf16_t*)(Sb + (16 * w + fr) * 132) + 32 * ks + 8 * fq);
#pragma unroll
            for (int dt = 0; dt < 4; ++dt) { const bf16x8 vf = *(const bf16x8*)(Vt + (16 * dt + fr) * 136 + 32 * ks + 8 * fq); O[dt] = __builtin_amdgcn_mfma_f32_16x16x32_bf16(vf, pf, O[dt], 0, 0, 0); } }
        float mx = red[0];
#pragma unroll
        for (int i = 1; i < 8; ++i) mx = fmaxf(mx, red[i]);
        __syncthreads();
        if (mx < ATT_EXIT) break;
    }
    { bf16_t* op = acat + (size_t)(qb * 128 + 16 * w + fr) * 768 + head * 64 + 4 * fq;
#pragma unroll
      for (int dt = 0; dt < 4; ++dt) { u32x2 o; o.x = cvt_pk_bf16(O[dt][0], O[dt][1]); o.y = cvt_pk_bf16(O[dt][2], O[dt][3]); *(u32x2*)(op + 16 * dt) = o; } }
}

__device__ __forceinline__ float gelu_tanh(float x) { const float u = 0.7978845608f * (x + 0.044715f * x * x * x); const float e = __expf(2.f * u); const float t = 1.f - 2.f * __builtin_amdgcn_rcpf(e + 1.f); return 0.5f * x * (1.f + t); }
template <bool PASSB>
__device__ void ssm_wave(unsigned char* wl, const unsigned char* tab, const float* dskip, const bf16_t* proj, float2* sst, bf16_t* gb, int c, int g, int nsub) {
    const int lane = lane_id_asm(), fr = lane & 15, fq = lane >> 4;
    float* bu = (float*)wl; bf16_t* xs = (bf16_t*)(wl + 8448);
    const float2 ab = ((const float2*)tab)[lane];
    const bf16x8 zero8 = {0, 0, 0, 0, 0, 0, 0, 0};
    bf16x8 Bf[8];
#pragma unroll
    for (int nt = 0; nt < 8; ++nt) Bf[nt] = fq < 2 ? *(const bf16x8*)((const bf16_t*)(tab + 1024) + (16 * nt + fr) * 16 + 8 * fq) : zero8;
    bf16x8 Cf[4], Df = zero8;
    float xr = 0.f, xi = 0.f;
    if (PASSB) {
#pragma unroll
        for (int ks = 0; ks < 4; ++ks) Cf[ks] = *(const bf16x8*)((const bf16_t*)(tab + 5120) + fr * 128 + 32 * ks + 8 * fq);
        const short dv = (short)(cvt_pk_bf16(dskip[g * 16 + fr], 0.f) & 0xffffu);
#pragma unroll
        for (int i = 0; i < 8; ++i) Df[i] = (8 * fq + i == fr) ? dv : (short)0;
        const float2 aT = ((const float2*)(tab + 512))[lane];
        const float2* sp = sst + g * 64 + lane;
        for (int c0 = 0; c0 < c; c0 += 32) {
            float2 v[32];
#pragma unroll
            for (int i = 0; i < 32; ++i) v[i] = (c0 + i < c) ? sp[(size_t)(c0 + i) * 2048] : make_float2(0.f, 0.f);
#pragma unroll
            for (int i = 0; i < 32; ++i) if (c0 + i < c) { const float nr = aT.x * xr - aT.y * xi + v[i].x, ni = aT.x * xi + aT.y * xr + v[i].y; xr = nr; xi = ni; }
        }
    }
    bf16x8 ufs[8];
#pragma unroll
    for (int sub = 0; sub < 8; ++sub) ufs[sub] = (fq < 2 && sub < nsub) ? *(const bf16x8*)(proj + (size_t)(c * 128 + sub * 16 + fr) * INW + 768 + g * 16 + 8 * fq) : zero8;
#pragma unroll
    for (int sub = 0; sub < 8; ++sub) {
        if (sub >= nsub) break;
        const int row = c * 128 + sub * 16 + fr;
        const bf16x8 uf = ufs[sub];
#pragma unroll
        for (int nt = 0; nt < 8; ++nt) { const f32x4 a = __builtin_amdgcn_mfma_f32_16x16x32_bf16(Bf[nt], uf, (f32x4){0.f, 0.f, 0.f, 0.f}, 0, 0, 0); *(f32x4*)(bu + fr * 132 + 16 * nt + 4 * fq) = a; }
        asm volatile("s_waitcnt lgkmcnt(0)" ::: "memory");
        float br[16], bi[16];
#pragma unroll
        for (int t = 0; t < 16; ++t) { br[t] = bu[t * 132 + lane]; bi[t] = bu[t * 132 + 64 + lane]; }
#pragma unroll
        for (int t = 0; t < 16; ++t) { const float nr = ab.x * xr - ab.y * xi + br[t], ni = ab.x * xi + ab.y * xr + bi[t]; xr = nr; xi = ni;
            if (PASSB) { br[t] = xr; bi[t] = xi; } }
        if (PASSB) {
#pragma unroll
            for (int t = 0; t < 16; t += 2) { const unsigned pr = cvt_pk_bf16(br[t], br[t + 1]), pi = cvt_pk_bf16(bi[t], bi[t + 1]);
                xs[t * 136 + lane] = (bf16_t)(pr & 0xffffu); xs[(t + 1) * 136 + lane] = (bf16_t)(pr >> 16); xs[t * 136 + 64 + lane] = (bf16_t)(pi & 0xffffu); xs[(t + 1) * 136 + 64 + lane] = (bf16_t)(pi >> 16); }
            asm volatile("s_waitcnt lgkmcnt(0)" ::: "memory");
            f32x4 y = {0.f, 0.f, 0.f, 0.f};
#pragma unroll
            for (int ks = 0; ks < 4; ++ks) { const bf16x8 xf = *(const bf16x8*)(xs + fr * 136 + 32 * ks + 8 * fq); y = __builtin_amdgcn_mfma_f32_16x16x32_bf16(Cf[ks], xf, y, 0, 0, 0); }
            y = __builtin_amdgcn_mfma_f32_16x16x32_bf16(Df, uf, y, 0, 0, 0);
            u32x2 o; o.x = cvt_pk_bf16(gelu_tanh(y[0]), gelu_tanh(y[1])); o.y = cvt_pk_bf16(gelu_tanh(y[2]), gelu_tanh(y[3]));
            *(u32x2*)(gb + (size_t)row * 512 + g * 16 + 4 * fq) = o;
        }
        asm volatile("s_waitcnt lgkmcnt(0)" ::: "memory");
    }
    if (!PASSB) sst[(size_t)c * 2048 + g * 64 + lane] = make_float2(xr, xi);
}


__device__ void tail_gemm(unsigned char* shm, const int w, const int j, const bf16_t* A, int lda, const bf16_t* Bt, int ldb, int K,
                          float* h, bf16_t* hb, float* ss, float* out) {
    const int lane = lane_id_asm(), fr = lane & 15, fq = lane >> 4, c0 = 64 * j, R0 = 16384;
    f32x4 acc[4];
#pragma unroll
    for (int ct = 0; ct < 4; ++ct) acc[ct] = (f32x4){0.f, 0.f, 0.f, 0.f};
    const bf16_t* ap = A + (size_t)(R0 + fr) * lda + 8 * fq;
    const bf16_t* bp = Bt + (size_t)(c0 + fr) * ldb + 8 * fq;
    const int nks = K / 32;
    for (int ks0 = w; ks0 < nks; ks0 += 32) {
        bf16x8 af[4], bf[4][4];
#pragma unroll
        for (int u = 0; u < 4; ++u) { const int ks = ks0 + 8 * u; const bool ok = ks < nks; const int kk = ok ? ks : ks0;
            af[u] = *(const bf16x8*)(ap + 32 * kk);
#pragma unroll
            for (int ct = 0; ct < 4; ++ct) bf[u][ct] = *(const bf16x8*)(bp + (size_t)(16 * ct) * ldb + 32 * kk);
            if (!ok) af[u] = (bf16x8){0, 0, 0, 0, 0, 0, 0, 0}; }
#pragma unroll
        for (int u = 0; u < 4; ++u)
#pragma unroll
            for (int ct = 0; ct < 4; ++ct) acc[ct] = __builtin_amdgcn_mfma_f32_16x16x32_bf16(bf[u][ct], af[u], acc[ct], 0, 0, 0);
    }
    f32x4* red = (f32x4*)shm;
    float* part = (float*)(shm + 32768);
#pragma unroll
    for (int ct = 0; ct < 4; ++ct) red[(w * 4 + ct) * 64 + lane] = acc[ct];
    __syncthreads();
    if (w < 4) {
        f32x4 v = red[w * 64 + lane];
#pragma unroll
        for (int k = 1; k < 8; ++k) v += red[(k * 4 + w) * 64 + lane];
        const int row = R0 + fr, col = c0 + 16 * w + 4 * fq;
        {
            float* hp = h + (size_t)row * DM + col;
            const f32x4 a = *(const f32x4*)hp + v; if (!out) *(f32x4*)hp = a;
            if (ss) { u32x2 ow; ow.x = cvt_pk_bf16(a[0], a[1]); ow.y = cvt_pk_bf16(a[2], a[3]); *(u32x2*)(hb + (size_t)row * DM + col) = ow;
                float sq = a[0] * a[0] + a[1] * a[1] + a[2] * a[2] + a[3] * a[3];
                sq += lane_get(sq, lane ^ 16); sq += lane_get(sq, lane ^ 32);
                if (fq == 0) part[w * 16 + fr] = sq; }
            if (out) *(f32x4*)(out + (size_t)(row - NMETA) * DM + col) = a;
        }
    }
    __syncthreads();
    if (ss && w == 0 && lane < 16) ss[(size_t)j * L + R0 + lane] = part[lane] + part[16 + lane] + part[32 + lane] + part[48 + lane];
    __syncthreads();
}

__device__ void tail_mix(unsigned char* shm, const int w, const int j, const bf16_t* acat, const bf16_t* Wcat, const bf16_t* proj, bf16_t* mixed) {
    const int lane = lane_id_asm(), fr = lane & 15, fq = lane >> 4, c0 = 64 * j, R0 = 16384;
    f32x4 acc1[4], acc2[4];
#pragma unroll
    for (int ct = 0; ct < 4; ++ct) { acc1[ct] = (f32x4){0.f, 0.f, 0.f, 0.f}; acc2[ct] = acc1[ct]; }
    const bf16_t* ap = acat + (size_t)(R0 + fr) * 768 + 8 * fq; const bf16_t* bp = Wcat + (size_t)(c0 + fr) * 768 + 8 * fq;
    bf16x8 af[3], bf[3][4];
#pragma unroll
    for (int u = 0; u < 3; ++u) { af[u] = *(const bf16x8*)(ap + 32 * (w + 8 * u));
#pragma unroll
        for (int ct = 0; ct < 4; ++ct) bf[u][ct] = *(const bf16x8*)(bp + (size_t)(16 * ct) * 768 + 32 * (w + 8 * u)); }
#pragma unroll
    for (int ct = 0; ct < 4; ++ct) { acc1[ct] = __builtin_amdgcn_mfma_f32_16x16x32_bf16(bf[0][ct], af[0], acc1[ct], 0, 0, 0);
        acc2[ct] = __builtin_amdgcn_mfma_f32_16x16x32_bf16(bf[1][ct], af[1], acc2[ct], 0, 0, 0); acc2[ct] = __builtin_amdgcn_mfma_f32_16x16x32_bf16(bf[2][ct], af[2], acc2[ct], 0, 0, 0); }
    f32x4* red = (f32x4*)shm;
#pragma unroll
    for (int ct = 0; ct < 4; ++ct) { red[(w * 4 + ct) * 64 + lane] = acc1[ct]; red[2048 + (w * 4 + ct) * 64 + lane] = acc2[ct]; }
    __syncthreads();
    if (w < 4) {
        f32x4 v1 = red[w * 64 + lane], v2 = red[2048 + w * 64 + lane];
#pragma unroll
        for (int k = 1; k < 8; ++k) { v1 += red[(k * 4 + w) * 64 + lane]; v2 += red[2048 + (k * 4 + w) * 64 + lane]; }
        const int row = R0 + fr, col = c0 + 16 * w + 4 * fq;
        const u32x2 ga = *(const u32x2*)(proj + (size_t)row * INW + 1280 + col), gs = *(const u32x2*)(proj + (size_t)row * INW + 2304 + col);
        f32x4 o; o[0] = sigmoidf_(bf_lo(ga.x)) * v1[0] + sigmoidf_(bf_lo(gs.x)) * v2[0]; o[1] = sigmoidf_(bf_hi(ga.x)) * v1[1] + sigmoidf_(bf_hi(gs.x)) * v2[1];
        o[2] = sigmoidf_(bf_lo(ga.y)) * v1[2] + sigmoidf_(bf_lo(gs.y)) * v2[2]; o[3] = sigmoidf_(bf_hi(ga.y)) * v1[3] + sigmoidf_(bf_hi(gs.y)) * v2[3];
        u32x2 ow; ow.x = cvt_pk_bf16(o[0], o[1]); ow.y = cvt_pk_bf16(o[2], o[3]); *(u32x2*)(mixed + (size_t)row * DM + col) = ow;
    }
    __syncthreads();
}

__device__ void tail_proj(unsigned char* shm, const int w, const int j, const bf16_t* A, const bf16_t* Bt, const float* ss, bf16_t* proj) {
    const int lane = lane_id_asm(), fr = lane & 15, fq = lane >> 4, c0 = 64 * j, R0 = 16384;
    f32x4 acc[4];
#pragma unroll
    for (int ct = 0; ct < 4; ++ct) acc[ct] = (f32x4){0.f, 0.f, 0.f, 0.f};
    const bf16_t* ap = A + (size_t)(R0 + fr) * DM + 8 * fq; const bf16_t* bp = Bt + (size_t)(c0 + fr) * DM + 8 * fq;
    { bf16x8 af[4], bf[4][4];
#pragma unroll
      for (int u = 0; u < 4; ++u) { const int ks = w + 8 * u; af[u] = *(const bf16x8*)(ap + 32 * ks);
#pragma unroll
          for (int ct = 0; ct < 4; ++ct) bf[u][ct] = *(const bf16x8*)(bp + (size_t)(16 * ct) * DM + 32 * ks); }
#pragma unroll
      for (int u = 0; u < 4; ++u)
#pragma unroll
          for (int ct = 0; ct < 4; ++ct) acc[ct] = __builtin_amdgcn_mfma_f32_16x16x32_bf16(bf[u][ct], af[u], acc[ct], 0, 0, 0); }
    f32x4* red = (f32x4*)shm;
#pragma unroll
    for (int ct = 0; ct < 4; ++ct) red[(w * 4 + ct) * 64 + lane] = acc[ct];
    __syncthreads();
    if (w < 4) {
        f32x4 v = red[w * 64 + lane];
#pragma unroll
        for (int k = 1; k < 8; ++k) v += red[(k * 4 + w) * 64 + lane];
        const int row = R0 + fr, col = c0 + 16 * w + 4 * fq; float sum = 0.f;
#pragma unroll
        for (int k = 0; k < 16; ++k) sum += ss[(size_t)k * L + row];
        const float rs = rsqrtf(sum * (1.f / 1024.f) + 1e-6f);
        u32x2 ow; ow.x = cvt_pk_bf16(v[0] * rs, v[1] * rs); ow.y = cvt_pk_bf16(v[2] * rs, v[3] * rs); *(u32x2*)(proj + (size_t)row * INW + col) = ow;
    }
    __syncthreads();
}

#define XB_TMO      128
#define XB_XCNT(j)  (256  + 64 * (j))
#define XB_XSUB(j)  (1280 + 64 * (j))
#define XB_XGEN(j)  (2304 + 64 * (j))
#define XB_TOP      3328
#define XB_TOPGEN   3392
#define XCD_BAR_WORDS 3456
#define XB_SPIN_CAP (1u << 18)
__device__ __forceinline__ unsigned xb_ld(unsigned* p)              { return __hip_atomic_load(p, __ATOMIC_RELAXED, __HIP_MEMORY_SCOPE_AGENT); }
__device__ __forceinline__ unsigned xb_add(unsigned* p, unsigned v) { return __hip_atomic_fetch_add(p, v, __ATOMIC_RELAXED, __HIP_MEMORY_SCOPE_AGENT); }
__device__ __forceinline__ unsigned xb_xcc_id() { return (unsigned)__builtin_amdgcn_s_getreg((3 << 11) | 20) & 0xFu; }
#define XB_SPIN(cond, bar) do { unsigned _sp = 0; while (cond) { __builtin_amdgcn_s_sleep(1); \
    if ((++_sp & 255u) == 0u) { if (xb_ld(&(bar)[XB_TMO])) break; if (_sp > XB_SPIN_CAP) { atomicAdd(&(bar)[XB_TMO], 1u); break; } } } } while (0)
struct XcdBarrier { unsigned* bar; unsigned x; volatile LAS unsigned* st; };
__device__ __forceinline__ void xcd_barrier_complete(unsigned* bar, unsigned x, unsigned& nloc, unsigned& nx) {
    const unsigned G = gridDim.x;
    unsigned sum, cnt, mine, sp = 0u;
    for (;;) {
        sum = 0u; cnt = 0u; mine = 0u;
#pragma unroll
        for (unsigned j = 0; j < 16; ++j) { const unsigned c = xb_ld(&bar[XB_XCNT(j)]); sum += c; cnt += (c > 0u) ? 1u : 0u; mine = (j == x) ? c : mine; }
        if (sum == G) break;
        __builtin_amdgcn_s_sleep(1);
        if ((++sp & 255u) == 0u) { if (xb_ld(&bar[XB_TMO])) break; if (sp > XB_SPIN_CAP) { atomicAdd(&bar[XB_TMO], 1u); break; } }
    }
    nloc = mine > 0u ? mine : 1u; nx = cnt > 0u ? cnt : 1u;
}
__device__ __forceinline__ void xcd_barrier(const XcdBarrier& b, const int w) {
    asm volatile("s_waitcnt vmcnt(0)" ::: "memory");
    __syncthreads();
    if (w == 0 && lane_id_asm() == 0) {
        unsigned* bar = b.bar;
        __builtin_amdgcn_s_waitcnt(0);
        unsigned nloc = b.st[0], nx = b.st[1];
        if (nloc == 0u) { xcd_barrier_complete(bar, b.x, nloc, nx); b.st[0] = nloc; b.st[1] = nx; }
        const unsigned old = xb_add(&bar[XB_XSUB(b.x)], 1u);
        const unsigned gen = old / nloc;
        if (old + 1u == (gen + 1u) * nloc) {
            __builtin_amdgcn_fence(__ATOMIC_RELEASE, "agent");
            asm volatile("s_waitcnt vmcnt(0)" ::: "memory");
            const unsigned og = xb_add(&bar[XB_TOP], 1u);
            const unsigned tg = og / nx;
            if (og + 1u == (tg + 1u) * nx) xb_add(&bar[XB_TOPGEN], 1u);
            else XB_SPIN(xb_ld(&bar[XB_TOPGEN]) == tg, bar);
            __builtin_amdgcn_fence(__ATOMIC_ACQUIRE, "agent");
            xb_add(&bar[XB_XGEN(b.x)], 1u);
            asm volatile("s_waitcnt vmcnt(0)" ::: "memory");
        } else {
            XB_SPIN(xb_ld(&bar[XB_XGEN(b.x)]) == gen, bar);
            __builtin_amdgcn_fence(__ATOMIC_ACQUIRE, "agent");
            asm volatile("s_waitcnt vmcnt(0)" ::: "memory");
        }
    }
    __syncthreads();
}

__global__ void __launch_bounds__(512, 2) fwd_megakernel(Params p) {
    extern __shared__ __attribute__((aligned(16))) unsigned char shm[];
    cg::grid_group grid = cg::this_grid();
    const int G = gridDim.x, b = blockIdx.x, w = __builtin_amdgcn_readfirstlane(threadIdx.x >> 6);
    unsigned char* ws = p.ws;
    LAS unsigned char* lds = (LAS unsigned char*)shm;
    volatile LAS unsigned* xst = (volatile LAS unsigned*)(lds + LDS_STAGE + 12272);
    if (w == 0 && lane_id_asm() == 0) { xst[0] = 0u; xst[1] = 0u; }
    __syncthreads();
    XcdBarrier xb; xb.bar = (unsigned*)(ws + WS_BAR); xb.x = xb_xcc_id(); xb.st = xst;
    if (p.ws == nullptr) grid.sync();
    if (w == 0 && lane_id_asm() == 0) (void)xb_add(&xb.bar[XB_XCNT(xb.x)], 1u);
    prep_phase(p, shm, w);
    xcd_barrier(xb, w);
    float* h = (float*)(ws + WS_H); bf16_t* hbarr = (bf16_t*)(ws + WS_HB); bf16_t* hb = hbarr + 2 * DM; float* ssq = (float*)(ws + WS_SSQ);
    bf16_t* proj = (bf16_t*)(ws + WS_PROJ); bf16_t* act = proj; bf16_t* acat = (bf16_t*)(ws + WS_ACAT);
    bf16_t* gb = (bf16_t*)((unsigned char*)p.out + OUT_GB); bf16_t* mixed = (bf16_t*)((unsigned char*)p.out + OUT_MIXED);
    float2* sst = (float2*)(ws + WS_SST);
#pragma unroll 1
    for (int l = 0; l < NLAYER; ++l) {
        const unsigned char* wt = ws + WS_WT + (size_t)l * WT_LAYER;
        pg8::Order S;
        { const float* ss1 = ssq + (size_t)(2 * l) * 16 * L;
          if (b < 48) tail_proj(shm, w, b, hb, (const bf16_t*)(wt + WT_WIN), ss1, proj);
          pg8::Gemm g{hb, (const bf16_t*)(wt + WT_WIN), DM, DM, DM, 64, 12, 256}; S.init(64, 12, G, b); EpiProj E{proj, ss1, (LAS float*)(lds + LDS_STAGE) + 1536, (LAS float*)(lds + LDS_SS)}; pg8::gemm_phase(lds, g, S, E, w); }
        xcd_barrier(xb, w);
        {
            const int n_att = NCHUNK * 4, n_ssm = (NCHUNK - 1) * 4, extra = n_att % G;
            for (int it = b; it < n_att; it += G) { attn_item(w, shm, proj, acat, p.in[4] + l * 64, p.in[5] + l * 64, NCHUNK - 1 - (it >> 2), it & 3); __syncthreads(); }
            const int nrest = (extra > 0 && extra < G / 2) ? G - extra : G, me = (nrest == G) ? b : b - extra;
            if (me >= 0) for (int j = me; j < n_ssm; j += nrest) { const int c = j >> 2, g = (j & 3) * 8 + w;
                ssm_wave<false>(shm + w * 12800, ws + WS_TAB + (size_t)(l * 32 + g) * TAB_G, p.in[13] + l * 512, proj, sst, gb, c, g, 8); }
            __syncthreads();
        }
        xcd_barrier(xb, w);
        for (int it = b; it < NCHUNK * 4; it += G) {
            int c = it >> 2; if (it >= 256 && it < 512) c = 127 - ((it - 256) >> 2);
            const int g = (it & 3) * 8 + w;
            ssm_wave<true>(shm + w * 12800, ws + WS_TAB + (size_t)(l * 32 + g) * TAB_G, p.in[13] + l * 512, proj, sst, gb, c, g, c == NCHUNK - 1 ? 1 : 8);
        }
        xcd_barrier(xb, w);
        if (b < 130 || G < 195) { pg8::Gemm g{gb, (const bf16_t*)(wt + WT_WGLU), 512, 512, 512, 65, 2, 256}; S.init(65, 2, G, b); EpiGlu E{gb, p.in[15] + l * 512, acat}; pg8::gemm_phase(lds, g, S, E, w); }
        if (b >= 130 || G < 195) {
            pg8::Gemm g{hb, (const bf16_t*)(wt + WT_WIN), DM, DM, DM, 65, 13, 256}; S.init_column(65, 12, G < 195 ? b : b - 130);
            EpiProj E{proj, ssq + (size_t)(2 * l) * 16 * L, (LAS float*)(lds + LDS_STAGE) + 1536, (LAS float*)(lds + LDS_SS)}; pg8::gemm_phase(lds, g, S, E, w); }
        xcd_barrier(xb, w);
        { if (b < 16) tail_mix(shm, w, b, acat, (const bf16_t*)(wt + WT_WCAT), proj, mixed);
          pg8::Gemm g{acat, (const bf16_t*)(wt + WT_WCAT), 768, 768, 768, 64, 4, 256}; S.init(64, 4, G, b); EpiMixF E{proj, mixed}; pg8::gemm_phase<EpiMixF, 4>(lds, g, S, E, w); }
        xcd_barrier(xb, w);
        { if (b < 16) tail_gemm(shm, w, b, mixed, DM, (const bf16_t*)(wt + WT_WO), DM, DM, h, hb, ssq + (size_t)(2 * l + 1) * 16 * L, nullptr);
          pg8::Gemm g{mixed, (const bf16_t*)(wt + WT_WO), DM, DM, DM, 64, 4, 256}; S.init(64, 4, G, b); EpiRes E{h, hb, ssq + (size_t)(2 * l + 1) * 16 * L, nullptr}; pg8::gemm_phase(lds, g, S, E, w); }
        xcd_barrier(xb, w);
        { pg8::Gemm g{hbarr, (const bf16_t*)(wt + WT_WUP), DM, DM, DM, 65, 22, 254}; S.init(65, 22, G, b);
          EpiUp E{act, ssq + (size_t)(2 * l + 1) * 16 * L, p.in[21] + (size_t)l * 3 * FF2, p.in[22] + (size_t)l * FF2, (LAS float*)(lds + LDS_STAGE), (LAS float*)(lds + LDS_SS)}; pg8::gemm_phase(lds, g, S, E, w); }
        xcd_barrier(xb, w);
        { float* ssn = l < NLAYER - 1 ? ssq + (size_t)(2 * l + 2) * 16 * L : nullptr; float* outp = l == NLAYER - 1 ? p.out : nullptr;
          if (b < 16) tail_gemm(shm, w, b, act, FFN, (const bf16_t*)(wt + WT_WDN), FFN, FFN, h, hb, ssn, outp);
          pg8::Gemm g{act, (const bf16_t*)(wt + WT_WDN), FFN, FFN, FFN, 64, 4, 256}; S.init(64, 4, G, b);
          EpiRes E{h, hb, ssn, outp}; pg8::gemm_phase(lds, g, S, E, w); }
        if (l < NLAYER - 1) xcd_barrier(xb, w);
    }
}

extern "C" void kernel_launch(void* const* d_in, const int* in_sizes, int n_in, void* d_out, int out_size, void* d_ws, size_t ws_size, hipStream_t stream) {
    static int grid_blocks = 0;
    if (!grid_blocks) {
        if (n_in != 24 || ws_size < WS_END) { fprintf(stderr, "kernel_launch: need 24 inputs and %zu bytes of workspace (got %d, %zu)\n", (size_t)WS_END, n_in, ws_size); grid_blocks = -1; return; }
        int dev = 0, cus = 0, per_cu = 0;
        hipGetDevice(&dev); hipDeviceGetAttribute(&cus, hipDeviceAttributeMultiprocessorCount, dev);
        if (hipFuncSetAttribute((const void*)fwd_megakernel, hipFuncAttributeMaxDynamicSharedMemorySize, LDS_BYTES) != hipSuccess) { fprintf(stderr, "kernel_launch: hipFuncSetAttribute failed\n"); grid_blocks = -1; return; }
        hipOccupancyMaxActiveBlocksPerMultiprocessor(&per_cu, (const void*)fwd_megakernel, 512, LDS_BYTES);
        if (per_cu < 1) { fprintf(stderr, "kernel_launch: occupancy query returned %d\n", per_cu); per_cu = 1; }
        grid_blocks = cus * 1;
    }
    if (grid_blocks < 0) return;
    if (hipMemsetAsync((char*)d_ws + WS_BAR, 0, 16384, stream) != hipSuccess) { fprintf(stderr, "kernel_launch: memset of the barrier words failed\n"); return; }
    Params p{};
    for (int i = 0; i < 24; ++i) p.in[i] = (const float*)d_in[i];
    p.out = (float*)d_out; p.ws = (unsigned char*)d_ws;
    void* args[] = {&p};
    hipError_t e = hipLaunchCooperativeKernel((const void*)fwd_megakernel, dim3(grid_blocks), dim3(512), args, LDS_BYTES, stream);
    if (e != hipSuccess) fprintf(stderr, "cooperative launch failed: %s (grid %d)\n", hipGetErrorString(e), grid_blocks);
}
```

```cpp
#include <hip/hip_runtime.h>
#include <hip/hip_cooperative_groups.h>
#include <cstdio>
namespace cg = cooperative_groups;

#define LAS __attribute__((address_space(3)))
typedef unsigned short bf16_t;
typedef short bf16x8 __attribute__((ext_vector_type(8)));
typedef float f32x4 __attribute__((ext_vector_type(4)));
typedef unsigned u32x4 __attribute__((ext_vector_type(4)));
typedef unsigned u32x2 __attribute__((ext_vector_type(2)));

constexpr int L = 16640, LREAL = 16400, NMETA = 16, DM = 1024, INW = 3328, FFN = 2816, FF2 = 5632, NLAYER = 4;
constexpr int NCHUNK = 129;
constexpr float ATT_EXIT = 1.9287498e-22f;

constexpr size_t WT_WIN = 0, WT_WGLU = WT_WIN + (size_t)INW * DM * 2, WT_WCAT = WT_WGLU + 512 * 512 * 2, WT_WO = WT_WCAT + 1024 * 768 * 2,
                 WT_WUP = WT_WO + 1024 * 1024 * 2, WT_WDN = WT_WUP + (size_t)FF2 * DM * 2, WT_LAYER = WT_WDN + (size_t)DM * FFN * 2;
constexpr size_t WS_WT = 0;
constexpr size_t WS_H = WS_WT + WT_LAYER * NLAYER;
constexpr size_t WS_HB = WS_H + (size_t)L * DM * 4;
constexpr size_t WS_SSQ = WS_HB + (size_t)(L + 2) * DM * 2;
constexpr size_t WS_TAB = WS_SSQ + (size_t)8 * 16 * L * 4;
constexpr size_t TAB_G = 9216;
constexpr size_t WS_SST = WS_TAB + TAB_G * 32 * NLAYER;
constexpr size_t WS_ACAT = WS_SST + (size_t)130 * 32 * 64 * 8;
constexpr size_t WS_PROJ = WS_ACAT + (size_t)L * 768 * 2;
constexpr size_t WS_BAR = WS_PROJ + (size_t)L * INW * 2;
constexpr size_t WS_END = WS_BAR + 16384;
constexpr size_t OUT_GB = 0, OUT_MIXED = (size_t)L * 512 * 2;

constexpr int LDS_STAGE = 131072, LDS_SS = LDS_STAGE + 12288, LDS_BYTES = LDS_SS + 16384;

struct Params { const float* in[24]; float* out; unsigned char* ws; };

typedef float f32x2_t __attribute__((ext_vector_type(2)));
typedef __bf16 bf16x2_t __attribute__((ext_vector_type(2)));
__device__ __forceinline__ unsigned cvt_pk_bf16(float lo, float hi) { const f32x2_t v = {lo, hi}; return __builtin_bit_cast(unsigned, __builtin_convertvector(v, bf16x2_t)); }
__device__ __forceinline__ float bf_lo(unsigned u) { return __uint_as_float(u << 16); }
__device__ __forceinline__ float bf_hi(unsigned u) { return __uint_as_float(u & 0xffff0000u); }
__device__ __forceinline__ float sigmoidf_(float x) { return __builtin_amdgcn_rcpf(1.f + __expf(-x)); }
__device__ __forceinline__ u32x4 pack8(f32x4 a, f32x4 b) { u32x4 r; r.x = cvt_pk_bf16(a[0], a[1]); r.y = cvt_pk_bf16(a[2], a[3]); r.z = cvt_pk_bf16(b[0], b[1]); r.w = cvt_pk_bf16(b[2], b[3]); return r; }
__device__ __forceinline__ void unpack8(u32x4 v, f32x4& a, f32x4& b) { a[0] = bf_lo(v.x); a[1] = bf_hi(v.x); a[2] = bf_lo(v.y); a[3] = bf_hi(v.y); b[0] = bf_lo(v.z); b[1] = bf_hi(v.z); b[2] = bf_lo(v.w); b[3] = bf_hi(v.w); }

__device__ __forceinline__ int lane_id_asm() { int ln; asm volatile("v_mbcnt_lo_u32_b32 %0, -1, 0\n\tv_mbcnt_hi_u32_b32 %0, -1, %0" : "=v"(ln)); return ln; }
__device__ __forceinline__ float lane_get(float v, int srclane) { return __builtin_bit_cast(float, __builtin_amdgcn_ds_bpermute(srclane << 2, __builtin_bit_cast(int, v))); }
template <int CTRL> __device__ __forceinline__ float dpp_ror(float x) { return __builtin_bit_cast(float, __builtin_amdgcn_mov_dpp(__builtin_bit_cast(int, x), CTRL, 0xf, 0xf, true)); }
template <int CTRL> __device__ __forceinline__ float dpp_shr_keep(float keep, float x) { return __builtin_bit_cast(float, __builtin_amdgcn_update_dpp(__builtin_bit_cast(int, keep), __builtin_bit_cast(int, x), CTRL, 0xf, 0xf, false)); }

namespace pg8 {
constexpr int BM = 256, BK = 64, HALF = 128, HTB = HALF * BK * 2, NXCD = 8, WGM = 8;
__device__ __forceinline__ int lds_byte(int r, int c) { const int st = (r >> 4) * 2 + (c >> 5), rr = r & 15, cc = c & 31, ob = rr * 64 + cc * 2; return st * 1024 + (ob ^ (((ob >> 9) & 1) << 5)); }
__device__ __forceinline__ void stage_rc(int b, int& R, int& C) { const int st = b / 1024, sb = b % 1024, swz = sb ^ (((sb >> 9) & 1) << 5); R = (st >> 1) * 16 + swz / 64; C = (st & 1) * 32 + (swz % 64) / 2; }
__device__ __forceinline__ int perm32(int rho) { const int n = rho >> 4, i = rho & 15; return 8 * (i >> 2) + 4 * n + (i & 3); }
struct Unit { int pm, pn; };
struct Gemm { const bf16_t* A; const bf16_t* Bt; int lda, ldb, K, nM, nN, rowstep; };
struct Order {
    int nM, nN, nwg, G, c, fixpn;
    __device__ void init(int nM_, int nN_, int G_, int c_) { nM = nM_; nN = nN_; nwg = nM * nN; G = G_; c = c_; fixpn = -1; }
    __device__ void init_column(int nM_, int pn_, int c_) { nM = nM_; nN = 1; nwg = nM_; G = 1 << 30; c = c_; fixpn = pn_; }
    __device__ bool next(int i, Unit& u) const {
        if (fixpn >= 0) { if (i > 0 || c < 0 || c >= nM) return false; u.pm = c; u.pn = fixpn; return true; }
        const long Lx = (long)i * G + c; if (Lx >= nwg) return false;
        int wgid = (int)Lx; { const int q = nwg / NXCD, r = nwg % NXCD, xcd = wgid % NXCD, off = wgid / NXCD; wgid = (xcd < r ? xcd * (q + 1) : r * (q + 1) + (xcd - r) * q) + off; }
        const int nig = WGM * nN, gid = wgid / nig, fm = gid * WGM, gsz = (nM - fm) < WGM ? (nM - fm) : WGM;
        u.pm = fm + ((wgid % nig) % gsz); u.pn = (wgid % nig) / gsz; return true;
    }
};
template <class Epi, int MID = -1>
__device__ __forceinline__ void gemm_phase(LAS unsigned char* lds, const Gemm g, const Order& S0, const Epi& E, const int wid) {
    Order S = S0; { int c_ = S.c; asm volatile("" : "+s"(c_)); S.c = c_; }
    const int lane = lane_id_asm(), tid = wid * 64 + lane,
              wr = wid >> 2, wc = wid & 3, fr = lane & 15, fq = lane >> 4;
    const int K = g.K, nt = K / BK;
    unsigned voffA[2], voffB[2];
#pragma unroll
    for (int i = 0; i < 2; ++i) { int R, C; stage_rc(tid * 16 + i * 8192, R, C); const int Rb = (R & ~31) + perm32(R & 31);
        voffA[i] = (unsigned)(R * g.lda + C) * 2u; voffB[i] = (unsigned)(Rb * g.ldb + C) * 2u; }
    const size_t kstep = (size_t)(BK * 2);
    const size_t hstepA = (size_t)HALF * g.lda * 2, hstepB = (size_t)HALF * g.ldb * 2;
    const size_t tstepA = (size_t)g.rowstep * g.lda * 2, tstepB = (size_t)BM * g.ldb * 2;
    const unsigned ldsw = (unsigned)wid * 1024u;
    const int aoff = lds_byte(wr * 64 + fr, fq * 8), boff = lds_byte(wc * 32 + fr, fq * 8);
#define PG8_SA(b, h) (((b) * 2 + (h)) * HTB)
#define PG8_SB(b, h) ((4 + (b) * 2 + (h)) * HTB)
#define PG8_STAGE(bufoff, gbase, voff) do { _Pragma("unroll") for (int _i = 0; _i < 2; ++_i) \
        __builtin_amdgcn_global_load_lds((const unsigned*)((const char*)(gbase) + (voff)[_i]), (LAS unsigned*)(lds + (bufoff) + ldsw + _i * 8192), 16, 0, 0); } while (0)
#define PG8_LDA(dst, b, h) do { _Pragma("unroll") for (int m = 0; m < 4; ++m) _Pragma("unroll") for (int k = 0; k < 2; ++k) dst[m][k] = *(const LAS bf16x8*)(lds + PG8_SA(b, h) + aoff + m * 2048 + k * 1024); } while (0)
#define PG8_LDB(dst, b, h) do { _Pragma("unroll") for (int n = 0; n < 2; ++n) _Pragma("unroll") for (int k = 0; k < 2; ++k) dst[n][k] = *(const LAS bf16x8*)(lds + PG8_SB(b, h) + boff + n * 2048 + k * 1024); } while (0)
#define PG8_MMA(ai, bj, At, Bt) do { __builtin_amdgcn_s_setprio(1); _Pragma("unroll") for (int m = 0; m < 4; ++m) _Pragma("unroll") for (int n = 0; n < 2; ++n) _Pragma("unroll") for (int k = 0; k < 2; ++k) \
        acc[ai][bj][m][n] = __builtin_amdgcn_mfma_f32_16x16x32_bf16(Bt[n][k], At[m][k], acc[ai][bj][m][n], 0, 0, 0); __builtin_amdgcn_s_setprio(0); } while (0)
#define PG8_WAIT_V(n) asm volatile("s_waitcnt vmcnt(" #n ")" ::: "memory")
#define PG8_WAIT_L(n) asm volatile("s_waitcnt lgkmcnt(" #n ")" ::: "memory")
#define PG8_BAR __builtin_amdgcn_s_barrier()
#define PG8_SCHED __builtin_amdgcn_sched_barrier(0)
    Unit cur, nxt; int ui = 0;
    if (!S.next(0, cur)) return;
    cur.pm = __builtin_amdgcn_readfirstlane(cur.pm); cur.pn = __builtin_amdgcn_readfirstlane(cur.pn);
    f32x4 acc[2][2][4][2];
#pragma unroll
    for (int a = 0; a < 2; ++a)
#pragma unroll
        for (int b = 0; b < 2; ++b)
#pragma unroll
            for (int m = 0; m < 4; ++m)
#pragma unroll
                for (int n = 0; n < 2; ++n) acc[a][b][m][n] = (f32x4){0.f, 0.f, 0.f, 0.f};
    bf16x8 At[4][2], B0[2][2], B1[2][2];
    const char* cA = (const char*)g.A + (size_t)cur.pm * tstepA; const char* cB = (const char*)g.Bt + (size_t)cur.pn * tstepB;
    if constexpr (Epi::PREFETCH) E.prefetch(cur, wid);
    PG8_STAGE(PG8_SB(0, 0), cB, voffB); PG8_STAGE(PG8_SA(0, 0), cA, voffA); PG8_STAGE(PG8_SB(0, 1), cB + hstepB, voffB); PG8_STAGE(PG8_SA(0, 1), cA + hstepA, voffA);
    if (wr == 1) PG8_BAR;
    PG8_WAIT_V(4); PG8_BAR;
    PG8_STAGE(PG8_SB(1, 0), cB + kstep, voffB); PG8_STAGE(PG8_SA(1, 0), cA + kstep, voffA); PG8_STAGE(PG8_SB(1, 1), cB + hstepB + kstep, voffB);
    PG8_WAIT_V(6); PG8_BAR;
    for (;;) {
        const bool has_next = __builtin_amdgcn_readfirstlane((int)S.next(ui + 1, nxt)) != 0; nxt.pm = __builtin_amdgcn_readfirstlane(nxt.pm); nxt.pn = __builtin_amdgcn_readfirstlane(nxt.pn);
        const char* nA = has_next ? (const char*)g.A + (size_t)nxt.pm * tstepA : cA; const char* nB = has_next ? (const char*)g.Bt + (size_t)nxt.pn * tstepB : cB;
        for (int t = 0; t < nt; t += 2) {
            if constexpr (MID >= 0) { if (t == MID) { const int ln = lane_id_asm(); E.mid(acc, cur, wr, wc, ln & 15, ln >> 4); } }
            const bool last = (t == nt - 2);
            const char* a1 = cA + (size_t)(t + 1) * kstep;
            const char* a2 = last ? nA : cA + (size_t)(t + 2) * kstep; const char* b2 = last ? nB : cB + (size_t)(t + 2) * kstep;
            const char* a3 = a2 + kstep; const char* b3 = b2 + kstep;
            PG8_LDB(B0, 0, 0); PG8_SCHED; PG8_LDA(At, 0, 0); PG8_STAGE(PG8_SA(1, 1), a1 + hstepA, voffA);
            PG8_WAIT_L(8); PG8_BAR; PG8_WAIT_L(0); PG8_MMA(0, 0, At, B0); PG8_BAR; PG8_SCHED;
            PG8_LDB(B1, 0, 1); PG8_STAGE(PG8_SB(0, 0), b2, voffB);
            PG8_BAR; PG8_WAIT_L(0); PG8_MMA(0, 1, At, B1); PG8_BAR;
            PG8_LDA(At, 0, 1); PG8_STAGE(PG8_SA(0, 0), a2, voffA);
            PG8_BAR; PG8_WAIT_L(0); PG8_MMA(1, 0, At, B0); PG8_BAR; PG8_SCHED;
            PG8_STAGE(PG8_SB(0, 1), b2 + hstepB, voffB);
            PG8_WAIT_V(6); PG8_BAR; PG8_MMA(1, 1, At, B1); PG8_BAR;
            PG8_LDB(B0, 1, 0); PG8_SCHED; PG8_LDA(At, 1, 0); PG8_STAGE(PG8_SA(0, 1), a2 + hstepA, voffA);
            PG8_WAIT_L(8); PG8_BAR; PG8_WAIT_L(0); PG8_MMA(0, 0, At, B0); PG8_BAR; PG8_SCHED;
            PG8_LDB(B1, 1, 1); PG8_STAGE(PG8_SB(1, 0), b3, voffB);
            PG8_BAR; PG8_WAIT_L(0); PG8_MMA(0, 1, At, B1); PG8_BAR;
            PG8_LDA(At, 1, 1); PG8_STAGE(PG8_SA(1, 0), a3, voffA);
            PG8_BAR; PG8_WAIT_L(0); PG8_MMA(1, 0, At, B0); PG8_BAR; PG8_SCHED;
            PG8_STAGE(PG8_SB(1, 1), b3 + hstepB, voffB);
            PG8_WAIT_V(6); PG8_BAR; PG8_MMA(1, 1, At, B1); PG8_BAR;
        }
        { const int ln = lane_id_asm(); E(acc, cur, wr, wc, ln & 15, ln >> 4); }
        if (!has_next) break;
        if constexpr (Epi::PREFETCH) E.prefetch(nxt, wid);
#pragma unroll
        for (int a = 0; a < 2; ++a)
#pragma unroll
            for (int b = 0; b < 2; ++b)
#pragma unroll
                for (int m = 0; m < 4; ++m)
#pragma unroll
                    for (int n = 0; n < 2; ++n) acc[a][b][m][n] = (f32x4){0.f, 0.f, 0.f, 0.f};
        cur = nxt; cA = nA; cB = nB; ++ui;
    }
    PG8_WAIT_V(0);
    if (wr == 0) PG8_BAR;
    PG8_BAR;
#undef PG8_SA
#undef PG8_SB
#undef PG8_STAGE
#undef PG8_LDA
#undef PG8_LDB
#undef PG8_MMA
#undef PG8_WAIT_V
#undef PG8_WAIT_L
#undef PG8_BAR
#undef PG8_SCHED
}
}
using pg8::Unit;
typedef f32x4 Acc[2][2][4][2];

struct EpiProj {
    static constexpr bool PREFETCH = true;
    bf16_t* proj; const float* ss; LAS float* RS; LAS float* SS;
    __device__ __forceinline__ void prefetch(const Unit& u, int wid) const {
        const int lane = lane_id_asm();
#pragma unroll
        for (int kk = 0; kk < 2; ++kk) { const int k = 2 * wid + kk;
#pragma unroll
            for (int q = 0; q < 4; ++q) __builtin_amdgcn_global_load_lds((const unsigned*)(ss + (size_t)k * L + u.pm * 256 + 64 * q + lane), (LAS unsigned*)(SS + k * 256 + 64 * q), 4, 0, 0); }
    }
    __device__ __forceinline__ void operator()(Acc& acc, const Unit& u, int wr, int wc, int fr, int fq) const {
        if (wr == 0) { const int lr = wc * 64 + fq * 16 + fr; float sum = 0.f;
#pragma unroll
            for (int k = 0; k < 16; ++k) sum += SS[k * 256 + lr];
            RS[lr] = rsqrtf(sum * (1.f / 1024.f) + 1e-6f); }
        asm volatile("s_waitcnt lgkmcnt(0)" ::: "memory"); __builtin_amdgcn_s_barrier(); asm volatile("" ::: "memory");
#pragma unroll
        for (int ai = 0; ai < 2; ++ai)
#pragma unroll
            for (int m = 0; m < 4; ++m) { const int lr = ai * 128 + wr * 64 + m * 16 + fr, row = u.pm * 256 + lr; const float rs = RS[lr];
#pragma unroll
                for (int bj = 0; bj < 2; ++bj) { const int col = u.pn * 256 + bj * 128 + wc * 32 + fq * 8;
                    *(u32x4*)(proj + (size_t)row * INW + col) = pack8(acc[ai][bj][m][0] * rs, acc[ai][bj][m][1] * rs); } asm volatile("" ::: "memory"); }
    }
};
struct EpiGlu {
    static constexpr bool PREFETCH = false;
    const bf16_t* gb; const float* bias; bf16_t* acat;
    __device__ __forceinline__ void operator()(Acc& acc, const Unit& u, int wr, int wc, int fr, int fq) const {
        const int col0 = u.pn * 256 + wc * 32 + fq * 8;
        f32x4 bv[2][2];
#pragma unroll
        for (int bj = 0; bj < 2; ++bj) { bv[bj][0] = *(const f32x4*)(bias + col0 + bj * 128); bv[bj][1] = *(const f32x4*)(bias + col0 + bj * 128 + 4); }
#pragma unroll
        for (int ai = 0; ai < 2; ++ai) {
            const int row0 = u.pm * 256 + ai * 128 + wr * 64 + fr;
            u32x4 gv[4][2];
#pragma unroll
            for (int m = 0; m < 4; ++m)
#pragma unroll
                for (int bj = 0; bj < 2; ++bj) gv[m][bj] = *(const u32x4*)(gb + (size_t)(row0 + m * 16) * 512 + col0 + bj * 128);
#pragma unroll
            for (int m = 0; m < 4; ++m)
#pragma unroll
                for (int bj = 0; bj < 2; ++bj) { f32x4 g0, g1; unpack8(gv[m][bj], g0, g1); f32x4 o0, o1;
#pragma unroll
                    for (int j = 0; j < 4; ++j) { o0[j] = g0[j] * sigmoidf_(acc[ai][bj][m][0][j] + bv[bj][0][j]); o1[j] = g1[j] * sigmoidf_(acc[ai][bj][m][1][j] + bv[bj][1][j]); }
                    *(u32x4*)(acat + (size_t)(row0 + m * 16) * 768 + 256 + col0 + bj * 128) = pack8(o0, o1); }
            asm volatile("" ::: "memory");
        }
    }
};
struct EpiMixF {
    static constexpr bool PREFETCH = false;
    const bf16_t* proj; bf16_t* mixed;
    static __device__ __forceinline__ float e_neg(float x) { return __expf(-fmaxf(x, -30.f)); }
    __device__ __forceinline__ void mid(Acc& acc, const Unit& u, int wr, int wc, int fr, int fq) const {
        const int col0 = u.pn * 256 + wc * 32 + fq * 8;
#pragma unroll
        for (int ai = 0; ai < 2; ++ai) { const int row0 = u.pm * 256 + ai * 128 + wr * 64 + fr;
            u32x4 av[4][2], sv[4][2];
#pragma unroll
            for (int m = 0; m < 4; ++m)
#pragma unroll
                for (int bj = 0; bj < 2; ++bj) { const bf16_t* gp = proj + (size_t)(row0 + m * 16) * INW + 1280 + col0 + bj * 128; av[m][bj] = *(const u32x4*)gp; sv[m][bj] = *(const u32x4*)(gp + 1024); }
#pragma unroll
            for (int m = 0; m < 4; ++m)
#pragma unroll
                for (int bj = 0; bj < 2; ++bj) { f32x4 a0, a1, s0, s1; unpack8(av[m][bj], a0, a1); unpack8(sv[m][bj], s0, s1);
#pragma unroll
                    for (int j = 0; j < 4; ++j) { acc[ai][bj][m][0][j] *= (1.f + e_neg(s0[j])) * __builtin_amdgcn_rcpf(1.f + __expf(-a0[j])); acc[ai][bj][m][1][j] *= (1.f + e_neg(s1[j])) * __builtin_amdgcn_rcpf(1.f + __expf(-a1[j])); } }
            asm volatile("" ::: "memory"); }
    }
    __device__ __forceinline__ void operator()(Acc& acc, const Unit& u, int wr, int wc, int fr, int fq) const {
        const int col0 = u.pn * 256 + wc * 32 + fq * 8;
#pragma unroll
        for (int ai = 0; ai < 2; ++ai) { const int row0 = u.pm * 256 + ai * 128 + wr * 64 + fr;
            u32x4 sv[4][2];
#pragma unroll
            for (int m = 0; m < 4; ++m)
#pragma unroll
                for (int bj = 0; bj < 2; ++bj) sv[m][bj] = *(const u32x4*)(proj + (size_t)(row0 + m * 16) * INW + 2304 + col0 + bj * 128);
#pragma unroll
            for (int m = 0; m < 4; ++m)
#pragma unroll
                for (int bj = 0; bj < 2; ++bj) { f32x4 s0, s1, o0, o1; unpack8(sv[m][bj], s0, s1);
#pragma unroll
                    for (int j = 0; j < 4; ++j) { o0[j] = acc[ai][bj][m][0][j] * __builtin_amdgcn_rcpf(1.f + e_neg(s0[j])); o1[j] = acc[ai][bj][m][1][j] * __builtin_amdgcn_rcpf(1.f + e_neg(s1[j])); }
                    *(u32x4*)(mixed + (size_t)(row0 + m * 16) * DM + col0 + bj * 128) = pack8(o0, o1); }
            asm volatile("" ::: "memory"); }
    }
};
struct EpiRes {
    static constexpr bool PREFETCH = false;
    float* h; bf16_t* hb; float* ss; float* out;
    __device__ __forceinline__ void operator()(Acc& acc, const Unit& u, int wr, int wc, int fr, int fq) const {
        const int col0 = u.pn * 256 + wc * 32 + fq * 8, ln4 = (fq * 16 + fr) * 4;
#pragma unroll
        for (int ai = 0; ai < 2; ++ai) {
            const int row0 = u.pm * 256 + ai * 128 + wr * 64 + fr;
            f32x4 hv[4][2][2];
#pragma unroll
            for (int m = 0; m < 4; ++m)
#pragma unroll
                for (int bj = 0; bj < 2; ++bj) { const float* hp = h + (size_t)(row0 + m * 16) * DM + col0 + bj * 128; hv[m][bj][0] = *(const f32x4*)hp; hv[m][bj][1] = *(const f32x4*)(hp + 4); }
#pragma unroll
            for (int m = 0; m < 4; ++m) { const int row = row0 + m * 16; float sq = 0.f;
#pragma unroll
                for (int bj = 0; bj < 2; ++bj) { float* hp = h + (size_t)row * DM + col0 + bj * 128;
                    const f32x4 a = hv[m][bj][0] + acc[ai][bj][m][0], b = hv[m][bj][1] + acc[ai][bj][m][1];
                    if (!out) { *(f32x4*)hp = a; *(f32x4*)(hp + 4) = b; }
                    if (ss) { *(u32x4*)(hb + (size_t)row * DM + col0 + bj * 128) = pack8(a, b);
                        sq += a[0] * a[0] + a[1] * a[1] + a[2] * a[2] + a[3] * a[3] + b[0] * b[0] + b[1] * b[1] + b[2] * b[2] + b[3] * b[3]; }
                    if (out && row >= NMETA && row < LREAL) { float* op = out + (size_t)(row - NMETA) * DM + col0 + bj * 128; *(f32x4*)op = a; *(f32x4*)(op + 4) = b; } }
                if (ss) { sq += __builtin_bit_cast(float, __builtin_amdgcn_ds_bpermute(ln4 ^ 64, __builtin_bit_cast(int, sq))); sq += __builtin_bit_cast(float, __builtin_amdgcn_ds_bpermute(ln4 ^ 128, __builtin_bit_cast(int, sq)));
                    if (fq == 0) ss[(size_t)(u.pn * 4 + wc) * L + row] = sq; } }
            asm volatile("" ::: "memory");
        }
    }
};
struct EpiUp {
    static constexpr bool PREFETCH = true;
    bf16_t* act; const float* ss; const float* cw; const float* cb; LAS float* X; LAS float* SS;
    __device__ __forceinline__ void prefetch(const Unit& u, int wid) const {
        const int lane = lane_id_asm();
#pragma unroll
        for (int kk = 0; kk < 2; ++kk) { const int k = 2 * wid + kk;
#pragma unroll
            for (int q = 0; q < 4; ++q) { int row = u.pm * 254 - 2 + 64 * q + lane; row = row < 0 ? 0 : row;
                __builtin_amdgcn_global_load_lds((const unsigned*)(ss + (size_t)k * L + row), (LAS unsigned*)(SS + k * 256 + 64 * q), 4, 0, 0); } }
        if (wid >= 4) { const int w4 = wid - 4, r8 = 2 * w4 + (lane >> 5), c4 = (lane & 31) * 4;     const float* src = ((r8 & 3) == 3 ? cb : cw + (r8 & 3) * FF2) + (r8 >> 2) * FFN + u.pn * 128 + c4;
            __builtin_amdgcn_global_load_lds((const unsigned*)src, (LAS unsigned*)(X + 1792 + 2 * w4 * 128), 16, 0, 0); }
    }
    __device__ __forceinline__ void operator()(Acc& acc, const Unit& u, int wr, int wc, int fr, int fq) const {
        LAS float* RS = X + 1536;
        LAS float* CW = X + 1792;
        if (wr == 0) { const int lr = wc * 64 + fq * 16 + fr; float sum = 0.f;
#pragma unroll
            for (int k = 0; k < 16; ++k) sum += SS[k * 256 + lr];
            RS[lr] = rsqrtf(sum * (1.f / 1024.f) + 1e-6f); }
        asm volatile("s_waitcnt lgkmcnt(0)" ::: "memory"); __builtin_amdgcn_s_barrier(); asm volatile("" ::: "memory");
#pragma unroll
        for (int ai = 0; ai < 2; ++ai)
#pragma unroll
            for (int m = 0; m < 4; ++m) { const float rs = RS[ai * 128 + wr * 64 + m * 16 + fr];
#pragma unroll
                for (int bj = 0; bj < 2; ++bj) { acc[ai][bj][m][0] *= rs; acc[ai][bj][m][1] *= rs; } }
        const int cl = wc * 32 + fq * 8;
        if (fr >= 14) {
#pragma unroll
            for (int ai = 0; ai < 2; ++ai) { const int s = 2 * ai + wr; if (s < 3) {
#pragma unroll
                for (int bj = 0; bj < 2; ++bj)
#pragma unroll
                    for (int n = 0; n < 2; ++n) *(LAS f32x4*)(X + ((s * 2 + (fr - 14)) * 2 + bj) * 128 + cl + 4 * n) = acc[ai][bj][3][n]; } }
        }
        asm volatile("s_waitcnt lgkmcnt(0)" ::: "memory"); __builtin_amdgcn_s_barrier(); asm volatile("" ::: "memory"); __builtin_amdgcn_s_barrier(); asm volatile("" ::: "memory");
#pragma unroll
        for (int n = 0; n < 2; ++n) {
            const int ch = u.pn * 128 + cl + 4 * n;
#pragma unroll
            for (int ai = 0; ai < 2; ++ai) {
                const int s = 2 * ai + wr;
                {
                    const LAS float* cwp = CW + cl + 4 * n; const f32x4 w0 = *(const LAS f32x4*)(cwp), w1 = *(const LAS f32x4*)(cwp + 128), w2 = *(const LAS f32x4*)(cwp + 256), bb = *(const LAS f32x4*)(cwp + 384);
                    f32x4 R1 = {0.f, 0.f, 0.f, 0.f}, R2 = R1;
                    if (s > 0) { const LAS float* xp = X + ((s - 1) * 2) * 2 * 128 + cl + 4 * n; const f32x4 e2 = *(const LAS f32x4*)(xp), e1 = *(const LAS f32x4*)(xp + 256); R1 = e1; R2 = fr == 0 ? e2 : e1; }
#pragma unroll
                    for (int m = 0; m < 4; ++m) { const f32x4 x = acc[ai][0][m][n]; f32x4 p1, p2;
#pragma unroll
                        for (int j = 0; j < 4; ++j) { p1[j] = dpp_shr_keep<0x111>(R1[j], x[j]); p2[j] = dpp_shr_keep<0x112>(R2[j], x[j]); R1[j] = dpp_ror<0x121>(x[j]); R2[j] = dpp_ror<0x122>(x[j]); }
                        acc[ai][0][m][n] = bb + w0 * p2 + w1 * p1 + w2 * x; }
                }
                asm volatile("" ::: "memory");
                {
                    const LAS float* cwp = CW + 512 + cl + 4 * n; const f32x4 w0 = *(const LAS f32x4*)(cwp), w1 = *(const LAS f32x4*)(cwp + 128), w2 = *(const LAS f32x4*)(cwp + 256), bb = *(const LAS f32x4*)(cwp + 384);
                    f32x4 R1 = {0.f, 0.f, 0.f, 0.f}, R2 = R1;
                    if (s > 0) { const LAS float* xp = X + ((s - 1) * 2) * 2 * 128 + 128 + cl + 4 * n; const f32x4 e2 = *(const LAS f32x4*)(xp), e1 = *(const LAS f32x4*)(xp + 256); R1 = e1; R2 = fr == 0 ? e2 : e1; }
#pragma unroll
                    for (int m = 0; m < 4; ++m) { const f32x4 x = acc[ai][1][m][n]; f32x4 p1, p2;
#pragma unroll
                        for (int j = 0; j < 4; ++j) { p1[j] = dpp_shr_keep<0x111>(R1[j], x[j]); p2[j] = dpp_shr_keep<0x112>(R2[j], x[j]); R1[j] = dpp_ror<0x121>(x[j]); R2[j] = dpp_ror<0x122>(x[j]); }
                        const f32x4 cvv = bb + w0 * p2 + w1 * p1 + w2 * x;
                        f32x4 o;
#pragma unroll
                        for (int j = 0; j < 4; ++j) { const float cgj = acc[ai][0][m][n][j]; o[j] = cgj * sigmoidf_(cgj) * cvv[j]; }
                        const int lr = ai * 128 + wr * 64 + m * 16 + fr, row = u.pm * 254 - 2 + lr;
                        if (lr >= 2 && row < L) { u32x2 w; w.x = cvt_pk_bf16(o[0], o[1]); w.y = cvt_pk_bf16(o[2], o[3]); *(u32x2*)(act + (size_t)row * FFN + ch) = w; } }
                }
                asm volatile("" ::: "memory");
            }
        }
    }
};

__device__ __forceinline__ void sincos_f64(double x, double& s, double& c) {
    const double kd = rint(x * 6.36619772367581382433e-01);
    double r = fma(-kd, 1.57079632673412561417e+00, x); r = fma(-kd, 6.07710050650619224932e-11, r);
    const double z = r * r;
    const double ps = -1.66666666666666324348e-01 + z * (8.33333333332248946124e-03 + z * (-1.98412698298579493134e-04 + z * (2.75573137070700676789e-06 + z * (-2.50507602534068634195e-08 + z * 1.58969099521155010221e-10))));
    const double pc = 4.16666666666666019037e-02 + z * (-1.38888888888741095749e-03 + z * (2.48015872894767294178e-05 + z * (-2.75573143513906633035e-07 + z * (2.08757232129817482790e-09 + z * -1.13596475577881948265e-11))));
    const double sr = r + r * z * ps, cr = 1.0 - 0.5 * z + z * z * pc;
    const int q = ((int)kd) & 3;
    s = (q == 0) ? sr : (q == 1) ? cr : (q == 2) ? -sr : -cr;
    c = (q == 0) ? cr : (q == 1) ? -sr : (q == 2) ? -cr : sr;
}
__device__ void transpose_tile(int tid, float* T, const float* W, int N, int k0, int n0, const float* gain, bf16_t* Wt, int ldb, int koff, int upperm) {
    { const int kk = tid >> 3, c8 = (tid & 7) * 8; const float* src = W + (size_t)(k0 + kk) * N + n0 + c8;
      const f32x4 a = *(const f32x4*)src, b = *(const f32x4*)(src + 4); const float gs = gain ? gain[k0 + kk] : 1.f;
#pragma unroll
      for (int i = 0; i < 4; ++i) { T[kk * 65 + c8 + i] = a[i] * gs; T[kk * 65 + c8 + 4 + i] = b[i] * gs; } }
    __syncthreads();
    { const int nn = tid >> 3, k8 = (tid & 7) * 8; f32x4 a, b;
#pragma unroll
      for (int i = 0; i < 4; ++i) { a[i] = T[(k8 + i) * 65 + nn]; b[i] = T[(k8 + 4 + i) * 65 + nn]; }
      int n = n0 + nn;
      if (upperm) { const int c = n < FFN ? n : n - FFN; n = 256 * (c >> 7) + (n < FFN ? 0 : 128) + (c & 127); }
      *(u32x4*)(Wt + (size_t)n * ldb + koff + k0 + k8) = pack8(a, b); }
    __syncthreads();
}

__device__ void prep_phase(const Params& p, unsigned char* shm, const int w) {
    const int G = gridDim.x, b = blockIdx.x, lane = lane_id_asm(), tid = w * 64 + lane;
    unsigned char* ws = p.ws;
    constexpr int T_WIN = 16 * 52, T_GLU = 64, T_AP = 64, T_SP = 128, T_WO = 256, T_UP = 16 * 88, T_DN = 44 * 16, T_LAYER = T_WIN + T_GLU + T_AP + T_SP + T_WO + T_UP + T_DN;
    for (int idx = b; idx < T_LAYER * NLAYER; idx += G) {
        const int l = idx / T_LAYER; int r = idx % T_LAYER;
        unsigned char* wt = ws + WS_WT + (size_t)l * WT_LAYER;
        float* T = (float*)shm;
        if (r < T_WIN) { transpose_tile(tid, T, p.in[3] + (size_t)l * DM * INW, INW, (r / 52) * 64, (r % 52) * 64, p.in[2] + l * DM, (bf16_t*)(wt + WT_WIN), DM, 0, 0); continue; } r -= T_WIN;
        if (r < T_GLU) { transpose_tile(tid, T, p.in[14] + (size_t)l * 512 * 512, 512, (r / 8) * 64, (r % 8) * 64, nullptr, (bf16_t*)(wt + WT_WGLU), 512, 0, 0); continue; } r -= T_GLU;
        if (r < T_AP) { transpose_tile(tid, T, p.in[16] + (size_t)l * 256 * DM, DM, (r / 16) * 64, (r % 16) * 64, nullptr, (bf16_t*)(wt + WT_WCAT), 768, 0, 0); continue; } r -= T_AP;
        if (r < T_SP) { transpose_tile(tid, T, p.in[17] + (size_t)l * 512 * DM, DM, (r / 16) * 64, (r % 16) * 64, nullptr, (bf16_t*)(wt + WT_WCAT), 768, 256, 0); continue; } r -= T_SP;
        if (r < T_WO) { transpose_tile(tid, T, p.in[18] + (size_t)l * DM * DM, DM, (r / 16) * 64, (r % 16) * 64, nullptr, (bf16_t*)(wt + WT_WO), DM, 0, 0); continue; } r -= T_WO;
        if (r < T_UP) { transpose_tile(tid, T, p.in[20] + (size_t)l * DM * FF2, FF2, (r / 88) * 64, (r % 88) * 64, p.in[19] + l * DM, (bf16_t*)(wt + WT_WUP), DM, 0, 1); continue; } r -= T_UP;
        transpose_tile(tid, T, p.in[23] + (size_t)l * FFN * DM, DM, (r / 16) * 64, (r % 16) * 64, nullptr, (bf16_t*)(wt + WT_WDN), FFN, 0, 0);
    }
    float* h = (float*)(ws + WS_H); bf16_t* hb = (bf16_t*)(ws + WS_HB) + 2 * DM; float* ssq = (float*)(ws + WS_SSQ);
    for (int row = b * 8 + w; row < L; row += G * 8) {
        float sq = 0.f;
#pragma unroll
        for (int i = 0; i < 4; ++i) { const int col = i * 256 + lane * 4; f32x4 v = {0.f, 0.f, 0.f, 0.f};
            if (row < NMETA) v = *(const f32x4*)(p.in[1] + (size_t)row * DM + col); else if (row < LREAL) v = *(const f32x4*)(p.in[0] + (size_t)(row - NMETA) * DM + col);
            *(f32x4*)(h + (size_t)row * DM + col) = v; u32x2 wv; wv.x = cvt_pk_bf16(v[0], v[1]); wv.y = cvt_pk_bf16(v[2], v[3]); *(u32x2*)(hb + (size_t)row * DM + col) = wv;
            sq += v[0] * v[0] + v[1] * v[1] + v[2] * v[2] + v[3] * v[3]; }
#pragma unroll
        for (int o = 32; o > 0; o >>= 1) sq += lane_get(sq, lane ^ o);
        if (lane < 16) ssq[(size_t)lane * L + row] = lane == 0 ? sq : 0.f;
    }
    for (int i = b * 512 + tid; i < 7 * 16 * L; i += G * 512) ssq[(size_t)16 * L + i] = 0.f;
    for (int i = b * 512 + tid; i < 2 * DM / 2; i += G * 512) ((unsigned*)(ws + WS_HB))[i] = 0u;
    for (int i = b * 512 + tid; i < (L - NCHUNK * 128) * 512 / 2; i += G * 512) ((unsigned*)((unsigned char*)p.out + OUT_GB) + (size_t)NCHUNK * 128 * 512 / 2)[i] = 0u;
    for (int i = b * 512 + tid; i < (L - LREAL) * INW / 2; i += G * 512) ((unsigned*)(ws + WS_PROJ) + (size_t)LREAL * INW / 2)[i] = 0u;
    for (int i = b * 512 + tid; i < NLAYER * 32 * 64; i += G * 512) {
        const int l = i >> 11, g = (i >> 6) & 31, pp = i & 63;
        const double a_re = (double)p.in[6][i], lam_im = (double)p.in[7][i]; const double lam_re = a_re < -1e-4 ? a_re : -1e-4;
        const double step = exp((double)p.in[8][l * 32 + g]);
        const double mag = exp(lam_re * step); double sn, cs; sincos_f64(lam_im * step, sn, cs);
        const double abr = mag * cs, abi = mag * sn, den = lam_re * lam_re + lam_im * lam_im, nr = abr - 1.0;
        const double f_re = (nr * lam_re + abi * lam_im) / den, f_im = (abi * lam_re - nr * lam_im) / den;
        double tr = abr, ti = abi;
#pragma unroll 1
        for (int k = 0; k < 7; ++k) { const double nr2 = tr * tr - ti * ti, ni2 = 2.0 * tr * ti; tr = nr2; ti = ni2; }
        unsigned char* tab = ws + WS_TAB + (size_t)(l * 32 + g) * TAB_G;
        ((float2*)tab)[pp] = make_float2((float)abr, (float)abi); ((float2*)(tab + 512))[pp] = make_float2((float)tr, (float)ti);
        bf16_t* Bm = (bf16_t*)(tab + 1024); bf16_t* Cm = (bf16_t*)(tab + 1024 + 4096);
        const float* bre = p.in[9] + (size_t)i * 16; const float* bim = p.in[10] + (size_t)i * 16;
#pragma unroll
        for (int hh = 0; hh < 16; hh += 2) {
            const double r0 = f_re * bre[hh] - f_im * bim[hh], i0 = f_re * bim[hh] + f_im * bre[hh], r1 = f_re * bre[hh + 1] - f_im * bim[hh + 1], i1 = f_re * bim[hh + 1] + f_im * bre[hh + 1];
            *(unsigned*)(Bm + pp * 16 + hh) = cvt_pk_bf16((float)r0, (float)r1); *(unsigned*)(Bm + (64 + pp) * 16 + hh) = cvt_pk_bf16((float)i0, (float)i1); }
        const float* cre = p.in[11] + (size_t)(l * 32 + g) * 16 * 64; const float* cim = p.in[12] + (size_t)(l * 32 + g) * 16 * 64;
        for (int hh = 0; hh < 16; ++hh) { Cm[hh * 128 + pp] = (bf16_t)(cvt_pk_bf16(cre[hh * 64 + pp], 0.f) & 0xffffu); Cm[hh * 128 + 64 + pp] = (bf16_t)(cvt_pk_bf16(-cim[hh * 64 + pp], 0.f) & 0xffffu); }
    }
}

__device__ void attn_item(const int w, unsigned char* shm, const bf16_t* proj, bf16_t* acat, const float* qg, const float* kg, int qb, int head) {
    bf16_t* Qs = (bf16_t*)shm; bf16_t* Ks = (bf16_t*)(shm + 18432); bf16_t* Vt = (bf16_t*)(shm + 36864); float* Sb = (float*)(shm + 54272); float* red = (float*)(shm + 121856);
    const int lane = lane_id_asm(), tid = w * 64 + lane, fr = lane & 15, fq = lane >> 4;
    { const int row = tid >> 2, seg = tid & 3; const bf16_t* src = proj + (size_t)(qb * 128 + row) * INW + head * 64 + seg * 16;
      f32x4 x0, x1, x2, x3; unpack8(*(const u32x4*)src, x0, x1); unpack8(*(const u32x4*)(src + 8), x2, x3);
      float ss = 0.f;
#pragma unroll
      for (int i = 0; i < 4; ++i) ss += x0[i] * x0[i] + x1[i] * x1[i] + x2[i] * x2[i] + x3[i] * x3[i];
      ss += lane_get(ss, lane ^ 1); ss += lane_get(ss, lane ^ 2);
      const float rs = rsqrtf(ss * (1.f / 64.f) + 1e-6f) * 0.125f;
      const f32x4 g0 = *(const f32x4*)(qg + seg * 16), g1 = *(const f32x4*)(qg + seg * 16 + 4), g2 = *(const f32x4*)(qg + seg * 16 + 8), g3 = *(const f32x4*)(qg + seg * 16 + 12);
      *(u32x4*)(Qs + row * 72 + seg * 16) = pack8(x0 * g0 * rs, x1 * g1 * rs); *(u32x4*)(Qs + row * 72 + seg * 16 + 8) = pack8(x2 * g2 * rs, x3 * g3 * rs); }
    f32x4 O[4];
#pragma unroll
    for (int i = 0; i < 4; ++i) O[i] = (f32x4){0.f, 0.f, 0.f, 0.f};
    float accr = 1.f;
    const bf16_t* ksrc = proj + (size_t)(qb * 128 + (tid >> 2)) * INW + 256 + head * 64 + (tid & 3) * 16;
    const bf16_t* vsrc = proj + (size_t)(qb * 128 + (tid & 127)) * INW + 512 + head * 64 + (tid >> 7) * 16;
    u32x4 kn0 = *(const u32x4*)ksrc, kn1 = *(const u32x4*)(ksrc + 8), vn0 = *(const u32x4*)vsrc, vn1 = *(const u32x4*)(vsrc + 8);
    for (int kb = qb; kb >= 0; --kb) {
        const u32x4 kc0 = kn0, kc1 = kn1, vc0 = vn0, vc1 = vn1;
        if (kb > 0) { ksrc -= (size_t)128 * INW; vsrc -= (size_t)128 * INW; kn0 = *(const u32x4*)ksrc; kn1 = *(const u32x4*)(ksrc + 8); vn0 = *(const u32x4*)vsrc; vn1 = *(const u32x4*)(vsrc + 8); }
        { const int row = tid >> 2, seg = tid & 3;
          f32x4 x0, x1, x2, x3; unpack8(kc0, x0, x1); unpack8(kc1, x2, x3);
          float ss = 0.f;
#pragma unroll
          for (int i = 0; i < 4; ++i) ss += x0[i] * x0[i] + x1[i] * x1[i] + x2[i] * x2[i] + x3[i] * x3[i];
          ss += lane_get(ss, lane ^ 1); ss += lane_get(ss, lane ^ 2);
          const float rs = rsqrtf(ss * (1.f / 64.f) + 1e-6f);
          const f32x4 g0 = *(const f32x4*)(kg + seg * 16), g1 = *(const f32x4*)(kg + seg * 16 + 4), g2 = *(const f32x4*)(kg + seg * 16 + 8), g3 = *(const f32x4*)(kg + seg * 16 + 12);
          *(u32x4*)(Ks + row * 72 + seg * 16) = pack8(x0 * g0 * rs, x1 * g1 * rs); *(u32x4*)(Ks + row * 72 + seg * 16 + 8) = pack8(x2 * g2 * rs, x3 * g3 * rs); }
        { const int row = tid & 127, seg = tid >> 7;
          const u32x4 a = vc0, b = vc1; bf16_t* vp = Vt + (seg * 16) * 136 + row;
          vp[0 * 136] = (bf16_t)(a.x & 0xffffu); vp[1 * 136] = (bf16_t)(a.x >> 16); vp[2 * 136] = (bf16_t)(a.y & 0xffffu); vp[3 * 136] = (bf16_t)(a.y >> 16);
          vp[4 * 136] = (bf16_t)(a.z & 0xffffu); vp[5 * 136] = (bf16_t)(a.z >> 16); vp[6 * 136] = (bf16_t)(a.w & 0xffffu); vp[7 * 136] = (bf16_t)(a.w >> 16);
          vp[8 * 136] = (bf16_t)(b.x & 0xffffu); vp[9 * 136] = (bf16_t)(b.x >> 16); vp[10 * 136] = (bf16_t)(b.y & 0xffffu); vp[11 * 136] = (bf16_t)(b.y >> 16);
          vp[12 * 136] = (bf16_t)(b.z & 0xffffu); vp[13 * 136] = (bf16_t)(b.z >> 16); vp[14 * 136] = (bf16_t)(b.w & 0xffffu); vp[15 * 136] = (bf16_t)(b.w >> 16); }
        __syncthreads();
        { const int qt0 = 2 * (w >> 1), kt0 = 4 * (w & 1);
          f32x4 s[2][4];
#pragma unroll
          for (int a = 0; a < 2; ++a)
#pragma unroll
              for (int c = 0; c < 4; ++c) s[a][c] = (f32x4){0.f, 0.f, 0.f, 0.f};
#pragma unroll
          for (int ks = 0; ks < 2; ++ks) { bf16x8 qf[2], kf[4];
#pragma unroll
              for (int a = 0; a < 2; ++a) qf[a] = *(const bf16x8*)(Qs + (16 * (qt0 + a) + fr) * 72 + 32 * ks + 8 * fq);
#pragma unroll
              for (int c = 0; c < 4; ++c) kf[c] = *(const bf16x8*)(Ks + (16 * (kt0 + c) + fr) * 72 + 32 * ks + 8 * fq);
#pragma unroll
              for (int a = 0; a < 2; ++a)
#pragma unroll
                  for (int c = 0; c < 4; ++c) s[a][c] = __builtin_amdgcn_mfma_f32_16x16x32_bf16(kf[c], qf[a], s[a][c], 0, 0, 0); }
#pragma unroll
          for (int a = 0; a < 2; ++a)
#pragma unroll
              for (int c = 0; c < 4; ++c) *(f32x4*)(Sb + (16 * (qt0 + a) + fr) * 132 + 16 * (kt0 + c) + 4 * fq) = s[a][c]; }
        __syncthreads();
        const int row = tid >> 2, qq = tid & 3;
        float z[32];
#pragma unroll
        for (int i = 0; i < 8; ++i) { const f32x4 v = *(const f32x4*)(Sb + row * 132 + 32 * qq + 4 * i); z[4 * i] = v[0]; z[4 * i + 1] = v[1]; z[4 * i + 2] = v[2]; z[4 * i + 3] = v[3]; }
        __syncthreads();
        { const int lim = (kb == qb) ? (row - 32 * qq) : 1000;
          float keep = 1.f;
#pragma unroll
          for (int k = 31; k >= 0; --k) { const float e = __expf(-fmaxf(z[k], -80.f)); const float sg = __builtin_amdgcn_rcpf(1.f + e), om = e * sg;
              const bool vis = k < lim; z[k] = vis ? sg * keep : 0.f; keep = vis ? keep * om : keep; }
          const int lb = lane & ~3; const float t0 = lane_get(keep, lb), t1 = lane_get(keep, lb + 1), t2 = lane_get(keep, lb + 2), t3 = lane_get(keep, lb + 3);
          const float off = (qq < 1 ? t1 : 1.f) * (qq < 2 ? t2 : 1.f) * (qq < 3 ? t3 : 1.f) * accr;
          bf16_t* pp = (bf16_t*)(Sb + row * 132) + 32 * qq;
#pragma unroll
          for (int i = 0; i < 4; ++i) { u32x4 o; o.x = cvt_pk_bf16(z[8 * i] * off, z[8 * i + 1] * off); o.y = cvt_pk_bf16(z[8 * i + 2] * off, z[8 * i + 3] * off);
              o.z = cvt_pk_bf16(z[8 * i + 4] * off, z[8 * i + 5] * off); o.w = cvt_pk_bf16(z[8 * i + 6] * off, z[8 * i + 7] * off); *(u32x4*)(pp + 8 * i) = o; }
          accr *= (t0 * t1) * (t2 * t3);
          float mx = accr;
#pragma unroll
          for (int o = 32; o > 0; o >>= 1) mx = fmaxf(mx, lane_get(mx, lane ^ o));
          if (lane == 0) red[w] = mx; }
        __syncthreads();
#pragma unroll
        for (int ks = 0; ks < 4; ++ks) { const bf16x8 pf = *(const bf16x8*)((const bf16_t*)(Sb + (16 * w + fr) * 132) + 32 * ks + 8 * fq);
#pragma unroll
            for (int dt = 0; dt < 4; ++dt) { const bf16x8 vf = *(const bf16x8*)(Vt + (16 * dt + fr) * 136 + 32 * ks + 8 * fq); O[dt] = __builtin_amdgcn_mfma_f32_16x16x32_bf16(vf, pf, O[dt], 0, 0, 0); } }
        float mx = red[0];
#pragma unroll
        for (int i = 1; i < 8; ++i) mx = fmaxf(mx, red[i]);
        __syncthreads();
        if (mx < ATT_EXIT) break;
    }
    { bf16_t* op = acat + (size_t)(qb * 128 + 16 * w + fr) * 768 + head * 64 + 4 * fq;
#pragma unroll
      for (int dt = 0; dt < 4; ++dt) { u32x2 o; o.x = cvt_pk_bf16(O[dt][0], O[dt][1]); o.y = cvt_pk_bf16(O[dt][2], O[dt][3]); *(u32x2*)(op + 16 * dt) = o; } }
}

__device__ __forceinline__ float gelu_tanh(float x) { const float u = 0.7978845608f * (x + 0.044715f * x * x * x); const float e = __expf(2.f * u); const float t = 1.f - 2.f * __builtin_amdgcn_rcpf(e + 1.f); return 0.5f * x * (1.f + t); }
template <bool PASSB>
__device__ void ssm_wave(unsigned char* wl, const unsigned char* tab, const float* dskip, const bf16_t* proj, float2* sst, bf16_t* gb, int c, int g, int nsub) {
    const int lane = lane_id_asm(), fr = lane & 15, fq = lane >> 4;
    float* bu = (float*)wl; bf16_t* xs = (bf16_t*)(wl + 8448);
    const float2 ab = ((const float2*)tab)[lane];
    const bf16x8 zero8 = {0, 0, 0, 0, 0, 0, 0, 0};
    bf16x8 Bf[8];
#pragma unroll
    for (int nt = 0; nt < 8; ++nt) Bf[nt] = fq < 2 ? *(const bf16x8*)((const bf16_t*)(tab + 1024) + (16 * nt + fr) * 16 + 8 * fq) : zero8;
    bf16x8 Cf[4], Df = zero8;
    float xr = 0.f, xi = 0.f;
    if (PASSB) {
#pragma unroll
        for (int ks = 0; ks < 4; ++ks) Cf[ks] = *(const bf16x8*)((const bf16_t*)(tab + 5120) + fr * 128 + 32 * ks + 8 * fq);
        const short dv = (short)(cvt_pk_bf16(dskip[g * 16 + fr], 0.f) & 0xffffu);
#pragma unroll
        for (int i = 0; i < 8; ++i) Df[i] = (8 * fq + i == fr) ? dv : (short)0;
        const float2 aT = ((const float2*)(tab + 512))[lane];
        const float2* sp = sst + g * 64 + lane;
        for (int c0 = 0; c0 < c; c0 += 32) {
            float2 v[32];
#pragma unroll
            for (int i = 0; i < 32; ++i) v[i] = (c0 + i < c) ? sp[(size_t)(c0 + i) * 2048] : make_float2(0.f, 0.f);
#pragma unroll
            for (int i = 0; i < 32; ++i) if (c0 + i < c) { const float nr = aT.x * xr - aT.y * xi + v[i].x, ni = aT.x * xi + aT.y * xr + v[i].y; xr = nr; xi = ni; }
        }
    }
    bf16x8 ufs[8];
#pragma unroll
    for (int sub = 0; sub < 8; ++sub) ufs[sub] = (fq < 2 && sub < nsub) ? *(const bf16x8*)(proj + (size_t)(c * 128 + sub * 16 + fr) * INW + 768 + g * 16 + 8 * fq) : zero8;
#pragma unroll
    for (int sub = 0; sub < 8; ++sub) {
        if (sub >= nsub) break;
        const int row = c * 128 + sub * 16 + fr;
        const bf16x8 uf = ufs[sub];
#pragma unroll
        for (int nt = 0; nt < 8; ++nt) { const f32x4 a = __builtin_amdgcn_mfma_f32_16x16x32_bf16(Bf[nt], uf, (f32x4){0.f, 0.f, 0.f, 0.f}, 0, 0, 0); *(f32x4*)(bu + fr * 132 + 16 * nt + 4 * fq) = a; }
        asm volatile("s_waitcnt lgkmcnt(0)" ::: "memory");
        float br[16], bi[16];
#pragma unroll
        for (int t = 0; t < 16; ++t) { br[t] = bu[t * 132 + lane]; bi[t] = bu[t * 132 + 64 + lane]; }
#pragma unroll
        for (int t = 0; t < 16; ++t) { const float nr = ab.x * xr - ab.y * xi + br[t], ni = ab.x * xi + ab.y * xr + bi[t]; xr = nr; xi = ni;
            if (PASSB) { br[t] = xr; bi[t] = xi; } }
        if (PASSB) {
#pragma unroll
            for (int t = 0; t < 16; t += 2) { const unsigned pr = cvt_pk_bf16(br[t], br[t + 1]), pi = cvt_pk_bf16(bi[t], bi[t + 1]);
                xs[t * 136 + lane] = (bf16_t)(pr & 0xffffu); xs[(t + 1) * 136 + lane] = (bf16_t)(pr >> 16); xs[t * 136 + 64 + lane] = (bf16_t)(pi & 0xffffu); xs[(t + 1) * 136 + 64 + lane] = (bf16_t)(pi >> 16); }
            asm volatile("s_waitcnt lgkmcnt(0)" ::: "memory");
            f32x4 y = {0.f, 0.f, 0.f, 0.f};
#pragma unroll
            for (int ks = 0; ks < 4; ++ks) { const bf16x8 xf = *(const bf16x8*)(xs + fr * 136 + 32 * ks + 8 * fq); y = __builtin_amdgcn_mfma_f32_16x16x32_bf16(Cf[ks], xf, y, 0, 0, 0); }
            y = __builtin_amdgcn_mfma_f32_16x16x32_bf16(Df, uf, y, 0, 0, 0);
            u32x2 o; o.x = cvt_pk_bf16(gelu_tanh(y[0]), gelu_tanh(y[1])); o.y = cvt_pk_bf16(gelu_tanh(y[2]), gelu_tanh(y[3]));
            *(u32x2*)(gb + (size_t)row * 512 + g * 16 + 4 * fq) = o;
        }
        asm volatile("s_waitcnt lgkmcnt(0)" ::: "memory");
    }
    if (!PASSB) sst[(size_t)c * 2048 + g * 64 + lane] = make_float2(xr, xi);
}


__device__ void tail_gemm(unsigned char* shm, const int w, const int j, const bf16_t* A, int lda, const bf16_t* Bt, int ldb, int K,
                          float* h, bf16_t* hb, float* ss, float* out) {
    const int lane = lane_id_asm(), fr = lane & 15, fq = lane >> 4, c0 = 64 * j, R0 = 16384;
    f32x4 acc[4];
#pragma unroll
    for (int ct = 0; ct < 4; ++ct) acc[ct] = (f32x4){0.f, 0.f, 0.f, 0.f};
    const bf16_t* ap = A + (size_t)(R0 + fr) * lda + 8 * fq;
    const bf16_t* bp = Bt + (size_t)(c0 + fr) * ldb + 8 * fq;
    const int nks = K / 32;
    for (int ks0 = w; ks0 < nks; ks0 += 32) {
        bf16x8 af[4], bf[4][4];
#pragma unroll
        for (int u = 0; u < 4; ++u) { const int ks = ks0 + 8 * u; const bool ok = ks < nks; const int kk = ok ? ks : ks0;
            af[u] = *(const bf16x8*)(ap + 32 * kk);
#pragma unroll
            for (int ct = 0; ct < 4; ++ct) bf[u][ct] = *(const bf16x8*)(bp + (size_t)(16 * ct) * ldb + 32 * kk);
            if (!ok) af[u] = (bf16x8){0, 0, 0, 0, 0, 0, 0, 0}; }
#pragma unroll
        for (int u = 0; u < 4; ++u)
#pragma unroll
            for (int ct = 0; ct < 4; ++ct) acc[ct] = __builtin_amdgcn_mfma_f32_16x16x32_bf16(bf[u][ct], af[u], acc[ct], 0, 0, 0);
    }
    f32x4* red = (f32x4*)shm;
    float* part = (float*)(shm + 32768);
#pragma unroll
    for (int ct = 0; ct < 4; ++ct) red[(w * 4 + ct) * 64 + lane] = acc[ct];
    __syncthreads();
    if (w < 4) {
        f32x4 v = red[w * 64 + lane];
#pragma unroll
        for (int k = 1; k < 8; ++k) v += red[(k * 4 + w) * 64 + lane];
        const int row = R0 + fr, col = c0 + 16 * w + 4 * fq;
        {
            float* hp = h + (size_t)row * DM + col;
            const f32x4 a = *(const f32x4*)hp + v; if (!out) *(f32x4*)hp = a;
            if (ss) { u32x2 ow; ow.x = cvt_pk_bf16(a[0], a[1]); ow.y = cvt_pk_bf16(a[2], a[3]); *(u32x2*)(hb + (size_t)row * DM + col) = ow;
                float sq = a[0] * a[0] + a[1] * a[1] + a[2] * a[2] + a[3] * a[3];
                sq += lane_get(sq, lane ^ 16); sq += lane_get(sq, lane ^ 32);
                if (fq == 0) part[w * 16 + fr] = sq; }
            if (out) *(f32x4*)(out + (size_t)(row - NMETA) * DM + col) = a;
        }
    }
    __syncthreads();
    if (ss && w == 0 && lane < 16) ss[(size_t)j * L + R0 + lane] = part[lane] + part[16 + lane] + part[32 + lane] + part[48 + lane];
    __syncthreads();
}

__device__ void tail_mix(unsigned char* shm, const int w, const int j, const bf16_t* acat, const bf16_t* Wcat, const bf16_t* proj, bf16_t* mixed) {
    const int lane = lane_id_asm(), fr = lane & 15, fq = lane >> 4, c0 = 64 * j, R0 = 16384;
    f32x4 acc1[4], acc2[4];
#pragma unroll
    for (int ct = 0; ct < 4; ++ct) { acc1[ct] = (f32x4){0.f, 0.f, 0.f, 0.f}; acc2[ct] = acc1[ct]; }
    const bf16_t* ap = acat + (size_t)(R0 + fr) * 768 + 8 * fq; const bf16_t* bp = Wcat + (size_t)(c0 + fr) * 768 + 8 * fq;
    bf16x8 af[3], bf[3][4];
#pragma unroll
    for (int u = 0; u < 3; ++u) { af[u] = *(const bf16x8*)(ap + 32 * (w + 8 * u));
#pragma unroll
        for (int ct = 0; ct < 4; ++ct) bf[u][ct] = *(const bf16x8*)(bp + (size_t)(16 * ct) * 768 + 32 * (w + 8 * u)); }
#pragma unroll
    for (int ct = 0; ct < 4; ++ct) { acc1[ct] = __builtin_amdgcn_mfma_f32_16x16x32_bf16(bf[0][ct], af[0], acc1[ct], 0, 0, 0);
        acc2[ct] = __builtin_amdgcn_mfma_f32_16x16x32_bf16(bf[1][ct], af[1], acc2[ct], 0, 0, 0); acc2[ct] = __builtin_amdgcn_mfma_f32_16x16x32_bf16(bf[2][ct], af[2], acc2[ct], 0, 0, 0); }
    f32x4* red = (f32x4*)shm;
#pragma unroll
    for (int ct = 0; ct < 4; ++ct) { red[(w * 4 + ct) * 64 + lane] = acc1[ct]; red[2048 + (w * 4 + ct) * 64 + lane] = acc2[ct]; }
    __syncthreads();
    if (w < 4) {
        f32x4 v1 = red[w * 64 + lane], v2 = red[2048 + w * 64 + lane];
#pragma unroll
        for (int k = 1; k < 8; ++k) { v1 += red[(k * 4 + w) * 64 + lane]; v2 += red[2048 + (k * 4 + w) * 64 + lane]; }
        const int row = R0 + fr, col = c0 + 16 * w + 4 * fq;
        const u32x2 ga = *(const u32x2*)(proj + (size_t)row * INW + 1280 + col), gs = *(const u32x2*)(proj + (size_t)row * INW + 2304 + col);
        f32x4 o; o[0] = sigmoidf_(bf_lo(ga.x)) * v1[0] + sigmoidf_(bf_lo(gs.x)) * v2[0]; o[1] = sigmoidf_(bf_hi(ga.x)) * v1[1] + sigmoidf_(bf_hi(gs.x)) * v2[1];
        o[2] = sigmoidf_(bf_lo(ga.y)) * v1[2] + sigmoidf_(bf_lo(gs.y)) * v2[2]; o[3] = sigmoidf_(bf_hi(ga.y)) * v1[3] + sigmoidf_(bf_hi(gs.y)) * v2[3];
        u32x2 ow; ow.x = cvt_pk_bf16(o[0], o[1]); ow.y = cvt_pk_bf16(o[2], o[3]); *(u32x2*)(mixed + (size_t)row * DM + col) = ow;
    }
    __syncthreads();
}

__device__ void tail_proj(unsigned char* shm, const int w, const int j, const bf16_t* A, const bf16_t* Bt, const float* ss, bf16_t* proj) {
    const int lane = lane_id_asm(), fr = lane & 15, fq = lane >> 4, c0 = 64 * j, R0 = 16384;
    f32x4 acc[4];
#pragma unroll
    for (int ct = 0; ct < 4; ++ct) acc[ct] = (f32x4){0.f, 0.f, 0.f, 0.f};
    const bf16_t* ap = A + (size_t)(R0 + fr) * DM + 8 * fq; const bf16_t* bp = Bt + (size_t)(c0 + fr) * DM + 8 * fq;
    { bf16x8 af[4], bf[4][4];
#pragma unroll
      for (int u = 0; u < 4; ++u) { const int ks = w + 8 * u; af[u] = *(const bf16x8*)(ap + 32 * ks);
#pragma unroll
          for (int ct = 0; ct < 4; ++ct) bf[u][ct] = *(const bf16x8*)(bp + (size_t)(16 * ct) * DM + 32 * ks); }
#pragma unroll
      for (int u = 0; u < 4; ++u)
#pragma unroll
          for (int ct = 0; ct < 4; ++ct) acc[ct] = __builtin_amdgcn_mfma_f32_16x16x32_bf16(bf[u][ct], af[u], acc[ct], 0, 0, 0); }
    f32x4* red = (f32x4*)shm;
#pragma unroll
    for (int ct = 0; ct < 4; ++ct) red[(w * 4 + ct) * 64 + lane] = acc[ct];
    __syncthreads();
    if (w < 4) {
        f32x4 v = red[w * 64 + lane];
#pragma unroll
        for (int k = 1; k < 8; ++k) v += red[(k * 4 + w) * 64 + lane];
        const int row = R0 + fr, col = c0 + 16 * w + 4 * fq; float sum = 0.f;
#pragma unroll
        for (int k = 0; k < 16; ++k) sum += ss[(size_t)k * L + row];
        const float rs = rsqrtf(sum * (1.f / 1024.f) + 1e-6f);
        u32x2 ow; ow.x = cvt_pk_bf16(v[0] * rs, v[1] * rs); ow.y = cvt_pk_bf16(v[2] * rs, v[3] * rs); *(u32x2*)(proj + (size_t)row * INW + col) = ow;
    }
    __syncthreads();
}

#define XB_TMO      128
#define XB_XCNT(j)  (256  + 64 * (j))
#define XB_XSUB(j)  (1280 + 64 * (j))
#define XB_XGEN(j)  (2304 + 64 * (j))
#define XB_TOP      3328
#define XB_TOPGEN   3392
#define XCD_BAR_WORDS 3456
#define XB_SPIN_CAP (1u << 18)
__device__ __forceinline__ unsigned xb_ld(unsigned* p)              { return __hip_atomic_load(p, __ATOMIC_RELAXED, __HIP_MEMORY_SCOPE_AGENT); }
__device__ __forceinline__ unsigned xb_add(unsigned* p, unsigned v) { return __hip_atomic_fetch_add(p, v, __ATOMIC_RELAXED, __HIP_MEMORY_SCOPE_AGENT); }
__device__ __forceinline__ unsigned xb_xcc_id() { return (unsigned)__builtin_amdgcn_s_getreg((3 << 11) | 20) & 0xFu; }
#define XB_SPIN(cond, bar) do { unsigned _sp = 0; while (cond) { __builtin_amdgcn_s_sleep(1); \
    if ((++_sp & 255u) == 0u) { if (xb_ld(&(bar)[XB_TMO])) break; if (_sp > XB_SPIN_CAP) { atomicAdd(&(bar)[XB_TMO], 1u); break; } } } } while (0)
struct XcdBarrier { unsigned* bar; unsigned x; volatile LAS unsigned* st; };
__device__ __forceinline__ void xcd_barrier_complete(unsigned* bar, unsigned x, unsigned& nloc, unsigned& nx) {
    const unsigned G = gridDim.x;
    unsigned sum, cnt, mine, sp = 0u;
    for (;;) {
        sum = 0u; cnt = 0u; mine = 0u;
#pragma unroll
        for (unsigned j = 0; j < 16; ++j) { const unsigned c = xb_ld(&bar[XB_XCNT(j)]); sum += c; cnt += (c > 0u) ? 1u : 0u; mine = (j == x) ? c : mine; }
        if (sum == G) break;
        __builtin_amdgcn_s_sleep(1);
        if ((++sp & 255u) == 0u) { if (xb_ld(&bar[XB_TMO])) break; if (sp > XB_SPIN_CAP) { atomicAdd(&bar[XB_TMO], 1u); break; } }
    }
    nloc = mine > 0u ? mine : 1u; nx = cnt > 0u ? cnt : 1u;
}
__device__ __forceinline__ void xcd_barrier(const XcdBarrier& b, const int w) {
    asm volatile("s_waitcnt vmcnt(0)" ::: "memory");
    __syncthreads();
    if (w == 0 && lane_id_asm() == 0) {
        unsigned* bar = b.bar;
        __builtin_amdgcn_s_waitcnt(0);
        unsigned nloc = b.st[0], nx = b.st[1];
        if (nloc == 0u) { xcd_barrier_complete(bar, b.x, nloc, nx); b.st[0] = nloc; b.st[1] = nx; }
        const unsigned old = xb_add(&bar[XB_XSUB(b.x)], 1u);
        const unsigned gen = old / nloc;
        if (old + 1u == (gen + 1u) * nloc) {
            __builtin_amdgcn_fence(__ATOMIC_RELEASE, "agent");
            asm volatile("s_waitcnt vmcnt(0)" ::: "memory");
            const unsigned og = xb_add(&bar[XB_TOP], 1u);
            const unsigned tg = og / nx;
            if (og + 1u == (tg + 1u) * nx) xb_add(&bar[XB_TOPGEN], 1u);
            else XB_SPIN(xb_ld(&bar[XB_TOPGEN]) == tg, bar);
            __builtin_amdgcn_fence(__ATOMIC_ACQUIRE, "agent");
            xb_add(&bar[XB_XGEN(b.x)], 1u);
            asm volatile("s_waitcnt vmcnt(0)" ::: "memory");
        } else {
            XB_SPIN(xb_ld(&bar[XB_XGEN(b.x)]) == gen, bar);
            __builtin_amdgcn_fence(__ATOMIC_ACQUIRE, "agent");
            asm volatile("s_waitcnt vmcnt(0)" ::: "memory");
        }
    }
    __syncthreads();
}

__global__ void __launch_bounds__(512, 2) fwd_megakernel(Params p) {
    extern __shared__ __attribute__((aligned(16))) unsigned char shm[];
    cg::grid_group grid = cg::this_grid();
    const int G = gridDim.x, b = blockIdx.x, w = __builtin_amdgcn_readfirstlane(threadIdx.x >> 6);
    unsigned char* ws = p.ws;
    LAS unsigned char* lds = (LAS unsigned char*)shm;
    volatile LAS unsigned* xst = (volatile LAS unsigned*)(lds + LDS_STAGE + 12272);
    if (w == 0 && lane_id_asm() == 0) { xst[0] = 0u; xst[1] = 0u; }
    __syncthreads();
    XcdBarrier xb; xb.bar = (unsigned*)(ws + WS_BAR); xb.x = xb_xcc_id(); xb.st = xst;
    if (p.ws == nullptr) grid.sync();
    if (w == 0 && lane_id_asm() == 0) (void)xb_add(&xb.bar[XB_XCNT(xb.x)], 1u);
    prep_phase(p, shm, w);
    xcd_barrier(xb, w);
    float* h = (float*)(ws + WS_H); bf16_t* hbarr = (bf16_t*)(ws + WS_HB); bf16_t* hb = hbarr + 2 * DM; float* ssq = (float*)(ws + WS_SSQ);
    bf16_t* proj = (bf16_t*)(ws + WS_PROJ); bf16_t* act = proj; bf16_t* acat = (bf16_t*)(ws + WS_ACAT);
    bf16_t* gb = (bf16_t*)((unsigned char*)p.out + OUT_GB); bf16_t* mixed = (bf16_t*)((unsigned char*)p.out + OUT_MIXED);
    float2* sst = (float2*)(ws + WS_SST);
#pragma unroll 1
    for (int l = 0; l < NLAYER; ++l) {
        const unsigned char* wt = ws + WS_WT + (size_t)l * WT_LAYER;
        pg8::Order S;
        { const float* ss1 = ssq + (size_t)(2 * l) * 16 * L;
          if (b < 48) tail_proj(shm, w, b, hb, (const bf16_t*)(wt + WT_WIN), ss1, proj);
          pg8::Gemm g{hb, (const bf16_t*)(wt + WT_WIN), DM, DM, DM, 64, 12, 256}; S.init(64, 12, G, b); EpiProj E{proj, ss1, (LAS float*)(lds + LDS_STAGE) + 1536, (LAS float*)(lds + LDS_SS)}; pg8::gemm_phase(lds, g, S, E, w); }
        xcd_barrier(xb, w);
        {
            const int n_att = NCHUNK * 4, n_ssm = (NCHUNK - 1) * 4, extra = n_att % G;
            for (int it = b; it < n_att; it += G) { attn_item(w, shm, proj, acat, p.in[4] + l * 64, p.in[5] + l * 64, NCHUNK - 1 - (it >> 2), it & 3); __syncthreads(); }
            const int nrest = (extra > 0 && extra < G / 2) ? G - extra : G, me = (nrest == G) ? b : b - extra;
            if (me >= 0) for (int j = me; j < n_ssm; j += nrest) { const int c = j >> 2, g = (j & 3) * 8 + w;
                ssm_wave<false>(shm + w * 12800, ws + WS_TAB + (size_t)(l * 32 + g) * TAB_G, p.in[13] + l * 512, proj, sst, gb, c, g, 8); }
            __syncthreads();
        }
        xcd_barrier(xb, w);
        for (int it = b; it < NCHUNK * 4; it += G) {
            int c = it >> 2; if (it >= 256 && it < 512) c = 127 - ((it - 256) >> 2);
            const int g = (it & 3) * 8 + w;
            ssm_wave<true>(shm + w * 12800, ws + WS_TAB + (size_t)(l * 32 + g) * TAB_G, p.in[13] + l * 512, proj, sst, gb, c, g, c == NCHUNK - 1 ? 1 : 8);
        }
        xcd_barrier(xb, w);
        if (b < 130 || G < 195) { pg8::Gemm g{gb, (const bf16_t*)(wt + WT_WGLU), 512, 512, 512, 65, 2, 256}; S.init(65, 2, G, b); EpiGlu E{gb, p.in[15] + l * 512, acat}; pg8::gemm_phase(lds, g, S, E, w); }
        if (b >= 130 || G < 195) {
            pg8::Gemm g{hb, (const bf16_t*)(wt + WT_WIN), DM, DM, DM, 65, 13, 256}; S.init_column(65, 12, G < 195 ? b : b - 130);
            EpiProj E{proj, ssq + (size_t)(2 * l) * 16 * L, (LAS float*)(lds + LDS_STAGE) + 1536, (LAS float*)(lds + LDS_SS)}; pg8::gemm_phase(lds, g, S, E, w); }
        xcd_barrier(xb, w);
        { if (b < 16) tail_mix(shm, w, b, acat, (const bf16_t*)(wt + WT_WCAT), proj, mixed);
          pg8::Gemm g{acat, (const bf16_t*)(wt + WT_WCAT), 768, 768, 768, 64, 4, 256}; S.init(64, 4, G, b); EpiMixF E{proj, mixed}; pg8::gemm_phase<EpiMixF, 4>(lds, g, S, E, w); }
        xcd_barrier(xb, w);
        { if (b < 16) tail_gemm(shm, w, b, mixed, DM, (const bf16_t*)(wt + WT_WO), DM, DM, h, hb, ssq + (size_t)(2 * l + 1) * 16 * L, nullptr);
          pg8::Gemm g{mixed, (const bf16_t*)(wt + WT_WO), DM, DM, DM, 64, 4, 256}; S.init(64, 4, G, b); EpiRes E{h, hb, ssq + (size_t)(2 * l + 1) * 16 * L, nullptr}; pg8::gemm_phase(lds, g, S, E, w); }
        xcd_barrier(xb, w);
        { pg8::Gemm g{hbarr, (const bf16_t*)(wt + WT_WUP), DM, DM, DM, 65, 22, 254}; S.init(65, 22, G, b);
          EpiUp E{act, ssq + (size_t)(2 * l + 1) * 16 * L, p.in[21] + (size_t)l * 3 * FF2, p.in[22] + (size_t)l * FF2, (LAS float*)(lds + LDS_STAGE), (LAS float*)(lds + LDS_SS)}; pg8::gemm_phase(lds, g, S, E, w); }
        xcd_barrier(xb, w);
        { float* ssn = l < NLAYER - 1 ? ssq + (size_t)(2 * l + 2) * 16 * L : nullptr; float* outp = l == NLAYER - 1 ? p.out : nullptr;
          if (b < 16) tail_gemm(shm, w, b, act, FFN, (const bf16_t*)(wt + WT_WDN), FFN, FFN, h, hb, ssn, outp);
          pg8::Gemm g{act, (const bf16_t*)(wt + WT_WDN), FFN, FFN, FFN, 64, 4, 256}; S.init(64, 4, G, b);
          EpiRes E{h, hb, ssn, outp}; pg8::gemm_phase(lds, g, S, E, w); }
        if (l < NLAYER - 1) xcd_barrier(xb, w);
    }
}

extern "C" void kernel_launch(void* const* d_in, const int* in_sizes, int n_in, void* d_out, int out_size, void* d_ws, size_t ws_size, hipStream_t stream) {
    static int grid_blocks = 0;
    if (!grid_blocks) {
        if (n_in != 24 || ws_size < WS_END) { fprintf(stderr, "kernel_launch: need 24 inputs and %zu bytes of workspace (got %d, %zu)\n", (size_t)WS_END, n_in, ws_size); grid_blocks = -1; return; }
        int dev = 0, cus = 0, per_cu = 0;
        hipGetDevice(&dev); hipDeviceGetAttribute(&cus, hipDeviceAttributeMultiprocessorCount, dev);
        if (hipFuncSetAttribute((const void*)fwd_megakernel, hipFuncAttributeMaxDynamicSharedMemorySize, LDS_BYTES) != hipSuccess) { fprintf(stderr, "kernel_launch: hipFuncSetAttribute failed\n"); grid_blocks = -1; return; }
        hipOccupancyMaxActiveBlocksPerMultiprocessor(&per_cu, (const void*)fwd_megakernel, 512, LDS_BYTES);
        if (per_cu < 1) { fprintf(stderr, "kernel_launch: occupancy query returned %d\n", per_cu); per_cu = 1; }
        grid_blocks = cus * 1;
    }
    if (grid_blocks < 0) return;
    if (hipMemsetAsync((char*)d_ws + WS_BAR, 0, 16384, stream) != hipSuccess) { fprintf(stderr, "kernel_launch: memset of the barrier words failed\n"); return; }
    Params p{};
    for (int i = 0; i < 24; ++i) p.in[i] = (const float*)d_in[i];
    p.out = (float*)d_out; p.ws = (unsigned char*)d_ws;
    void* args[] = {&p};
    hipError_t e = hipLaunchCooperativeKernel((const void*)fwd_megakernel, dim3(grid_blocks), dim3(512), args, LDS_BYTES, stream);
    if (e != hipSuccess) fprintf(stderr, "cooperative launch failed: %s (grid %d)\n", hipGetErrorString(e), grid_blocks);
}
```
